# Optimizing an MI355X kernel written in HIP

```python
import jax, jax.numpy as jnp
from jax import lax
import numpy as np

D_MODEL = 4096
BATCH = 8
SEQ = 2048
DEPTH = 2

N_MIXERS = 2
POOL_WINDOWS = (2, 4, 8, 16)
N_POOL_GROUPS = len(POOL_WINDOWS)
POOL_GROUP = D_MODEL // N_POOL_GROUPS
GLA_HEADS = 4
GLA_KEY_DIM = D_MODEL // 2
GLA_VAL_DIM = D_MODEL
GLA_HEAD_K = GLA_KEY_DIM // GLA_HEADS
GLA_HEAD_V = GLA_VAL_DIM // GLA_HEADS
GATE_RANK = 16
GATE_TAU = 16.0
CHUNK = 64
D_FF = 4 * D_MODEL
EPS = 1e-6
N_POOL_LAYERS = (DEPTH + 1) // 2
N_GLA_LAYERS = DEPTH // 2
PROJ_WIDTH = 2 * GLA_KEY_DIM + 2 * GLA_VAL_DIM + 2 * GATE_RANK

kernel_name = "hybrid_pool_gla_encoder"


def rmsnorm(x, g):
    xf = x.astype(jnp.float32)
    y = xf * lax.rsqrt(jnp.mean(xf * xf, axis=-1, keepdims=True) + EPS)
    return (y * g.astype(jnp.float32)).astype(x.dtype)


def pool_mixer(h, w_group, scale):
    B, S, D = h.shape
    hf = h.astype(jnp.float32)
    csum = jnp.concatenate([jnp.zeros((B, 1, D), jnp.float32), jnp.cumsum(hf, axis=1)], axis=1)
    pos = jnp.arange(S)
    diffs = []
    for g, w in enumerate(POOL_WINDOWS):
        lo = jnp.clip(pos - w // 2, 0, S)
        hi = jnp.clip(pos + w // 2, 0, S)
        sl = slice(g * POOL_GROUP, (g + 1) * POOL_GROUP)
        cs = csum[..., sl]
        count = (hi - lo).astype(jnp.float32)[None, :, None]
        mean = (cs[:, hi] - cs[:, lo]) / count
        diffs.append(mean - hf[..., sl])
    d = jnp.stack(diffs, axis=2).astype(h.dtype)
    y = jnp.einsum('bsgc,gcd->bsgd', d, w_group).reshape(B, S, D)
    return y * scale


def gla_chunked(q, k, v, log_a):
    B, S, H, dk = q.shape
    dv = v.shape[-1]
    n_chunks = S // CHUNK

    def to_chunks(t):
        return t.astype(jnp.float32).reshape(B, n_chunks, CHUNK, H, -1).transpose(1, 0, 3, 2, 4)

    qc, kc, vc, gc = to_chunks(q), to_chunks(k), to_chunks(v), to_chunks(log_a)
    b = jnp.cumsum(gc, axis=3)
    b_last = b[..., CHUNK - 1:, :]
    b_mid = b[..., CHUNK // 2 - 1:CHUNK // 2, :]
    scores = jnp.einsum('nbhik,nbhjk->nbhij', qc * jnp.exp(b - b_mid), kc * jnp.exp(b_mid - b))
    mask = jnp.tril(jnp.ones((CHUNK, CHUNK), dtype=bool))
    scores = jnp.where(mask, scores, 0.0)
    o_intra = jnp.einsum('nbhij,nbhjv->nbhiv', scores, vc)
    q_inter = qc * jnp.exp(b)
    k_state = kc * jnp.exp(b_last - b)
    a_chunk = jnp.exp(b_last[..., 0, :])

    def step(state, inp):
        qi, ki, vi, ai = inp
        o = jnp.einsum('bhik,bhkv->bhiv', qi, state)
        state = ai[..., None] * state + jnp.einsum('bhjk,bhjv->bhkv', ki, vi)
        return state, o

    state0 = jnp.zeros((B, H, dk, dv), jnp.float32)
    _, o_inter = lax.scan(step, state0, (q_inter, k_state, vc, a_chunk))
    o = o_intra + o_inter
    return o.transpose(1, 0, 3, 2, 4).reshape(B, S, H, dv)


def gla_mixer(h, w_in, w_up_f, b_up_f, w_up_b, b_up_b, g_norm, w_out):
    B, S, D = h.shape
    p = h @ w_in
    c1 = GLA_KEY_DIM
    c2 = 2 * GLA_KEY_DIM
    c3 = c2 + GLA_VAL_DIM
    c4 = c3 + GLA_VAL_DIM
    c5 = c4 + GATE_RANK
    q, k, v, gate, r_f, r_b = jnp.split(p, [c1, c2, c3, c4, c5], axis=-1)
    q = q.reshape(B, S, GLA_HEADS, GLA_HEAD_K) * (GLA_HEAD_K ** -0.5)
    k = k.reshape(B, S, GLA_HEADS, GLA_HEAD_K)
    v = v.reshape(B, S, GLA_HEADS, GLA_HEAD_V)
    log_a_f = jax.nn.log_sigmoid((r_f @ w_up_f + b_up_f).astype(jnp.float32)) / GATE_TAU
    log_a_b = jax.nn.log_sigmoid((r_b @ w_up_b + b_up_b).astype(jnp.float32)) / GATE_TAU
    log_a_f = log_a_f.reshape(B, S, GLA_HEADS, GLA_HEAD_K)
    log_a_b = log_a_b.reshape(B, S, GLA_HEADS, GLA_HEAD_K)
    o_fwd = gla_chunked(q, k, v, log_a_f)
    flip = lambda t: jnp.flip(t, axis=1)
    o_bwd = flip(gla_chunked(flip(q), flip(k), flip(v), flip(log_a_b)))
    o = o_fwd + o_bwd
    o = o * lax.rsqrt(jnp.mean(o * o, axis=-1, keepdims=True) + EPS) * g_norm.astype(jnp.float32)
    o = o.reshape(B, S, GLA_VAL_DIM) * jax.nn.silu(gate.astype(jnp.float32))
    return o.astype(h.dtype) @ w_out


def relu2_mlp(h, w1, w2):
    a = jax.nn.relu(h @ w1)
    return (a * a) @ w2


def setup_inputs(seed: int = 0) -> dict:
    key = jax.random.key(seed)
    ks = jax.random.split(key, 16)
    f32 = jnp.float32
    nrm = lambda k, shape, s: (jax.random.normal(k, shape, f32) * s).astype(f32)
    return {
        "x": nrm(ks[0], (BATCH, SEQ, D_MODEL), 1.0),
        "norm_mix": 1.0 + nrm(ks[1], (DEPTH, D_MODEL), 0.02),
        "norm_mlp": 1.0 + nrm(ks[2], (DEPTH, D_MODEL), 0.02),
        "norm_final": 1.0 + nrm(ks[3], (D_MODEL,), 0.02),
        "pool_w": nrm(ks[4], (N_POOL_LAYERS, N_POOL_GROUPS, POOL_GROUP, POOL_GROUP), POOL_GROUP ** -0.5),
        "pool_scale": 1.0 + nrm(ks[5], (N_POOL_LAYERS, D_MODEL), 0.02),
        "gla_w_in": nrm(ks[6], (N_GLA_LAYERS, D_MODEL, PROJ_WIDTH), D_MODEL ** -0.5),
        "gla_w_up_f": nrm(ks[7], (N_GLA_LAYERS, GATE_RANK, GLA_KEY_DIM), GATE_RANK ** -0.5),
        "gla_b_up_f": nrm(ks[8], (N_GLA_LAYERS, GLA_KEY_DIM), 0.1),
        "gla_w_up_b": nrm(ks[9], (N_GLA_LAYERS, GATE_RANK, GLA_KEY_DIM), GATE_RANK ** -0.5),
        "gla_b_up_b": nrm(ks[10], (N_GLA_LAYERS, GLA_KEY_DIM), 0.1),
        "gla_g_norm": 1.0 + nrm(ks[11], (N_GLA_LAYERS, GLA_HEAD_V), 0.02),
        "gla_w_out": nrm(ks[12], (N_GLA_LAYERS, GLA_VAL_DIM, D_MODEL), GLA_VAL_DIM ** -0.5),
        "mlp_w_in": nrm(ks[13], (DEPTH, D_MODEL, D_FF), D_MODEL ** -0.5),
        "mlp_w_out": nrm(ks[14], (DEPTH, D_FF, D_MODEL), D_FF ** -0.5),
    }


def reference(x, norm_mix, norm_mlp, norm_final, pool_w, pool_scale, gla_w_in, gla_w_up_f,
              gla_b_up_f, gla_w_up_b, gla_b_up_b, gla_g_norm, gla_w_out, mlp_w_in, mlp_w_out):
    h = x
    for layer in range(DEPTH):
        j = layer // N_MIXERS
        hn = rmsnorm(h, norm_mix[layer])
        if layer % N_MIXERS == 0:
            h = h + pool_mixer(hn, pool_w[j], pool_scale[j])
        else:
            h = h + gla_mixer(hn, gla_w_in[j], gla_w_up_f[j], gla_b_up_f[j], gla_w_up_b[j],
                              gla_b_up_b[j], gla_g_norm[j], gla_w_out[j])
        hn = rmsnorm(h, norm_mlp[layer])
        h = h + relu2_mlp(hn, mlp_w_in[layer], mlp_w_out[layer])
    return rmsnorm(h, norm_final)
```

```cpp
#include <hip/hip_runtime.h>
#include <cstdio>
#include <cstdint>

#ifndef MK_PER_PHASE
#define MK_PER_PHASE 1
#endif

constexpr int BATCH = 8, SEQ = 2048, DM = 4096, M = BATCH * SEQ, FF = 4 * DM;
constexpr int NH = 4, KD = DM / 2, VD = DM, HK = KD / NH, HV = VD / NH, GR = 16;
constexpr int PW = 2 * KD + 2 * VD + 2 * GR;
constexpr int PWP = 12544;
constexpr float EPS = 1e-6f;
constexpr int NPHASE = 13;

constexpr size_t MiB = 1u << 20;
constexpr size_t WS_CTL = 0, CTL_ZERO_BYTES = 1 * MiB;
constexpr size_t WS_WPOOL = 2 * MiB;
constexpr size_t WS_WOUT = 10 * MiB;
constexpr size_t WS_WIN = 42 * MiB;
constexpr size_t WS_W1 = 140 * MiB;
constexpr size_t WS_W2 = 396 * MiB;
constexpr size_t WS_XN = 652 * MiB;
constexpr size_t WS_D = 780 * MiB;
constexpr size_t WS_HID = 908 * MiB;
constexpr size_t WS_Q = 908 * MiB;
constexpr size_t WS_K = 972 * MiB;
constexpr size_t WS_V = 1036 * MiB;
constexpr size_t WS_G = 1164 * MiB;
constexpr size_t WS_R = 1292 * MiB;
constexpr size_t WS_AD = 1294 * MiB;
constexpr size_t WS_O = 1550 * MiB;
constexpr size_t WS_RSTD0 = 1806 * MiB;
constexpr size_t WS_END = 1807 * MiB;
constexpr int CW_BAR = 4096;
constexpr int CW_SS = 131072;

constexpr int LDS_BYTES = 159 * 1024;
constexpr int RING_BYTES = 131072;
constexpr int MISC_OFF = LDS_BYTES - 256;

#define GAS __attribute__((address_space(1)))
#define LAS __attribute__((address_space(3)))
typedef unsigned short bf16;
typedef unsigned v4u __attribute__((ext_vector_type(4)));
typedef unsigned v2u __attribute__((ext_vector_type(2)));
typedef float f32x4 __attribute__((ext_vector_type(4)));
typedef short bf16x8 __attribute__((ext_vector_type(8)));
#define LDS_WAIT() asm volatile("s_waitcnt lgkmcnt(0)" ::: "memory")
#define VM_WAIT() asm volatile("s_waitcnt vmcnt(0)" ::: "memory")
__device__ __forceinline__ unsigned f2bf(float f) { unsigned u = __builtin_bit_cast(unsigned, f); return (u + 0x7fffu + ((u >> 16) & 1u)) >> 16; }
__device__ __forceinline__ unsigned pk2(float lo, float hi) { return f2bf(lo) | (f2bf(hi) << 16); }
__device__ __forceinline__ float bf2f(unsigned short b) { return __builtin_bit_cast(float, ((unsigned)b) << 16); }
__device__ __forceinline__ float ld_agent(const float* p) { return __builtin_bit_cast(float, __hip_atomic_load((const unsigned*)p, __ATOMIC_RELAXED, __HIP_MEMORY_SCOPE_AGENT)); }

namespace pg8 {
#define PG8_LAS __attribute__((address_space(3)))
typedef unsigned short bf16_t;
typedef unsigned u32x4 __attribute__((ext_vector_type(4)));
constexpr int BM = 256, BK = 64, HALF = 128, HTB = HALF * BK * 2, STAGE_BYTES = 8 * HTB, NXCD = 8, WGM = 8;

__host__ __device__ __forceinline__ int lds_byte(int r, int c) { const int st = (r >> 4) * 2 + (c >> 5), rr = r & 15, cc = c & 31, ob = rr * 64 + cc * 2; return st * 1024 + (ob ^ (((ob >> 9) & 1) << 5)); }
__host__ __device__ __forceinline__ void stage_rc(int b, int& R, int& C) { const int st = b / 1024, sb = b % 1024, swz = sb ^ (((sb >> 9) & 1) << 5); R = (st >> 1) * 16 + swz / 64; C = (st & 1) * 32 + (swz % 64) / 2; }
__host__ __device__ __forceinline__ int perm32(int rho) { const int n = rho >> 4, i = rho & 15; return 8 * (i >> 2) + 4 * n + (i & 3); }

struct Unit { int pm, pn; };
struct Gemm { const bf16_t* A; const bf16_t* Bt; int M, N, K, lda, grp; };

struct StaticOrder {
    int nM, nN, nwg, G, c;
    __host__ __device__ void init(int M_, int N_, int G_, int c_) { nM = M_ / BM; nN = N_ / BM; nwg = nM * nN; G = G_; c = c_; }
    __host__ __device__ bool next(int i, Unit& u) const {
        const long L = (long)i * G + c; if (L >= nwg) return false;
        int wgid = (int)L; { const int q = nwg / NXCD, r = nwg % NXCD, xcd = wgid % NXCD, off = wgid / NXCD; wgid = (xcd < r ? xcd * (q + 1) : r * (q + 1) + (xcd - r) * q) + off; }
        const int nig = WGM * nN, gid = wgid / nig, fm = gid * WGM, gsz = (nM - fm) < WGM ? (nM - fm) : WGM;
        u.pm = fm + ((wgid % nig) % gsz); u.pn = (wgid % nig) / gsz; return true;
    }
    __device__ __forceinline__ void a_ready(const Unit&) const {}
    __device__ __forceinline__ void done(const Unit&) const {}
};

__device__ __forceinline__ unsigned cvt_pk_bf16(float lo, float hi) { unsigned r; asm volatile("v_cvt_pk_bf16_f32 %0, %1, %2" : "=v"(r) : "v"(lo), "v"(hi)); return r; }


struct EpiResid {
    static constexpr bool PERM = true, AFTER_DRAIN = false;
    const float* hin; float* hout; const float* cscale; const float* gnext; bf16_t* xn; float* ss; int ldc;
    __device__ __forceinline__ void operator()(const f32x4 (&acc)[2][2][4][2], const Unit& u, int wr, int wc, int fr, int fq) const {
        const int row0 = u.pm * BM + wr * 64 + fr, col0 = u.pn * BM + wc * 32 + 8 * fq;
        f32x4 sc[2][2], gn[2][2];
#pragma unroll
        for (int bj = 0; bj < 2; ++bj)
#pragma unroll
            for (int n = 0; n < 2; ++n) {
                sc[bj][n] = cscale ? *(const f32x4*)(cscale + col0 + bj * HALF + 4 * n) : (f32x4){1.f, 1.f, 1.f, 1.f};
                gn[bj][n] = gnext ? *(const f32x4*)(gnext + col0 + bj * HALF + 4 * n) : (f32x4){1.f, 1.f, 1.f, 1.f};
            }
#pragma unroll
        for (int ai = 0; ai < 2; ++ai)
#pragma unroll
            for (int m = 0; m < 4; ++m) {
                const int r = row0 + ai * HALF + m * 16; const size_t off = (size_t)r * ldc + col0; float s = 0.f;
#pragma unroll
                for (int bj = 0; bj < 2; ++bj) {
                    const f32x4 h0 = *(const f32x4*)(hin + off + bj * HALF), h1 = *(const f32x4*)(hin + off + bj * HALF + 4);
                    const f32x4 v0 = h0 + acc[ai][bj][m][0] * sc[bj][0], v1 = h1 + acc[ai][bj][m][1] * sc[bj][1];
                    *(f32x4*)(hout + off + bj * HALF) = v0; *(f32x4*)(hout + off + bj * HALF + 4) = v1;
                    s += (v0[0] * v0[0] + v0[1] * v0[1]) + (v0[2] * v0[2] + v0[3] * v0[3]) + (v1[0] * v1[0] + v1[1] * v1[1]) + (v1[2] * v1[2] + v1[3] * v1[3]);
                    if (xn) { const f32x4 a = v0 * gn[bj][0], b = v1 * gn[bj][1]; u32x4 w; w.x = cvt_pk_bf16(a[0], a[1]); w.y = cvt_pk_bf16(a[2], a[3]); w.z = cvt_pk_bf16(b[0], b[1]); w.w = cvt_pk_bf16(b[2], b[3]);
                        *(u32x4*)(xn + off + bj * HALF) = w; }
                }
                s += __shfl_xor(s, 16); s += __shfl_xor(s, 32);
                if (fq == 0) unsafeAtomicAdd(ss + r, s);
                asm volatile("" ::: "memory");
            }
    }
};
struct EpiRelu2 {
    static constexpr bool PERM = true, AFTER_DRAIN = false;
    bf16_t* O; int ldc; const float* ss;
    __device__ __forceinline__ void operator()(const f32x4 (&acc)[2][2][4][2], const Unit& u, int wr, int wc, int fr, int fq) const {
        const int row0 = u.pm * BM + wr * 64 + fr, col0 = u.pn * BM + wc * 32 + 8 * fq;
#pragma unroll
        for (int ai = 0; ai < 2; ++ai)
#pragma unroll
            for (int m = 0; m < 4; ++m) {
                const int r = row0 + ai * HALF + m * 16; const float rs = 1.0f / sqrtf(ld_agent(ss + r) * (1.0f / DM) + EPS);
                bf16_t* rowp = O + (size_t)r * ldc + col0;
#pragma unroll
                for (int bj = 0; bj < 2; ++bj) { f32x4 v0 = acc[ai][bj][m][0] * rs, v1 = acc[ai][bj][m][1] * rs;
#pragma unroll
                    for (int j = 0; j < 4; ++j) { const float a = fmaxf(v0[j], 0.f), b = fmaxf(v1[j], 0.f); v0[j] = a * a; v1[j] = b * b; }
                    u32x4 w; w.x = cvt_pk_bf16(v0[0], v0[1]); w.y = cvt_pk_bf16(v0[2], v0[3]); w.z = cvt_pk_bf16(v1[0], v1[1]); w.w = cvt_pk_bf16(v1[2], v1[3]);
                    *(u32x4*)(rowp + bj * HALF) = w; }
            }
    }
};
struct EpiInProj {
    static constexpr bool PERM = true, AFTER_DRAIN = false;
    bf16_t *Q, *K, *V, *G; float* R; const float* ss;
    __device__ __forceinline__ void operator()(const f32x4 (&acc)[2][2][4][2], const Unit& u, int wr, int wc, int fr, int fq) const {
        const int row0 = u.pm * BM + wr * 64 + fr; const int pn = u.pn;
        bf16_t* base; int ldc, colt;
        if (pn < 8) { base = Q; ldc = KD; colt = pn * BM; } else if (pn < 16) { base = K; ldc = KD; colt = (pn - 8) * BM; }
        else if (pn < 32) { base = V; ldc = VD; colt = (pn - 16) * BM; } else { base = G; ldc = VD; colt = (pn - 32) * BM; }
        const int col0 = colt + wc * 32 + 8 * fq;
#pragma unroll
        for (int ai = 0; ai < 2; ++ai)
#pragma unroll
            for (int m = 0; m < 4; ++m) {
                const int r = row0 + ai * HALF + m * 16; const float rs = 1.0f / sqrtf(ld_agent(ss + r) * (1.0f / DM) + EPS);
                if (pn < 48) {
                    bf16_t* rowp = base + (size_t)r * ldc + col0;
#pragma unroll
                    for (int bj = 0; bj < 2; ++bj) { const f32x4 v0 = acc[ai][bj][m][0] * rs, v1 = acc[ai][bj][m][1] * rs;
                        u32x4 w; w.x = cvt_pk_bf16(v0[0], v0[1]); w.y = cvt_pk_bf16(v0[2], v0[3]); w.z = cvt_pk_bf16(v1[0], v1[1]); w.w = cvt_pk_bf16(v1[2], v1[3]);
                        *(u32x4*)(rowp + bj * HALF) = w; }
                } else if (wc == 0) {
                    float* rp = R + (size_t)r * 32 + 8 * fq;
                    *(f32x4*)rp = acc[ai][0][m][0] * rs; *(f32x4*)(rp + 4) = acc[ai][0][m][1] * rs;
                }
            }
    }
};

template <class Epi, class Sched, bool ALIGN_EPI = true>
__device__ __forceinline__ void gemm_phase(PG8_LAS unsigned char* lds, const Gemm g, const Sched& S, const Epi& E) {
    const int tid = threadIdx.x, wid = __builtin_amdgcn_readfirstlane(tid >> 6), lane = tid & 63, wr = wid >> 2, wc = wid & 3, fr = lane & 15, fq = lane >> 4;
    const int K = g.K, nt = K / BK, lda = g.lda;
    unsigned voffA[2], voffB[2];
#pragma unroll
    for (int i = 0; i < 2; ++i) { int R, C; stage_rc(tid * 16 + i * 8192, R, C); const int Rb = Epi::PERM ? ((R & ~31) + perm32(R & 31)) : R;
        voffA[i] = (unsigned)(R * lda + C) * 2u; voffB[i] = (unsigned)(Rb * K + C) * 2u; }
    const size_t kstep = (size_t)(BK * 2);
    const size_t hstepA = (size_t)HALF * lda * 2, hstepB = (size_t)HALF * K * 2;
    const size_t tstepA = 2 * hstepA, tstepB = 2 * hstepB;
    const unsigned ldsw = (unsigned)wid * 1024u;
    const int aoff = lds_byte(wr * 64 + fr, fq * 8), boff = lds_byte(wc * 32 + fr, fq * 8);
#define PG8_SA(b, h) (((b) * 2 + (h)) * HTB)
#define PG8_SB(b, h) ((4 + (b) * 2 + (h)) * HTB)
#define PG8_STAGE(bufoff, gbase, voff) do { _Pragma("unroll") for (int _i = 0; _i < 2; ++_i) \
        __builtin_amdgcn_global_load_lds((const unsigned*)((const char*)(gbase) + (voff)[_i]), (PG8_LAS unsigned*)(lds + (bufoff) + ldsw + _i * 8192), 16, 0, 0); } while (0)
#define PG8_LDA(dst, b, h) do { _Pragma("unroll") for (int m = 0; m < 4; ++m) _Pragma("unroll") for (int k = 0; k < 2; ++k) dst[m][k] = *(const PG8_LAS bf16x8*)(lds + PG8_SA(b, h) + aoff + m * 2048 + k * 1024); } while (0)
#define PG8_LDB(dst, b, h) do { _Pragma("unroll") for (int n = 0; n < 2; ++n) _Pragma("unroll") for (int k = 0; k < 2; ++k) dst[n][k] = *(const PG8_LAS bf16x8*)(lds + PG8_SB(b, h) + boff + n * 2048 + k * 1024); } while (0)
#define PG8_MMA(ai, bj, At, Bt) do { __builtin_amdgcn_s_setprio(1); _Pragma("unroll") for (int m = 0; m < 4; ++m) _Pragma("unroll") for (int n = 0; n < 2; ++n) _Pragma("unroll") for (int k = 0; k < 2; ++k) \
        acc[ai][bj][m][n] = __builtin_amdgcn_mfma_f32_16x16x32_bf16(Bt[n][k], At[m][k], acc[ai][bj][m][n], 0, 0, 0); __builtin_amdgcn_s_setprio(0); } while (0)
#define PG8_WAIT_V(n) asm volatile("s_waitcnt vmcnt(" #n ")" ::: "memory")
#define PG8_WAIT_L(n) asm volatile("s_waitcnt lgkmcnt(" #n ")" ::: "memory")
#define PG8_BAR __builtin_amdgcn_s_barrier()
#define PG8_SCHED __builtin_amdgcn_sched_barrier(0)
#define PG8_AOFF(u) ((size_t)(u).pm * tstepA + (g.grp ? (size_t)((u).pn / g.grp) * (size_t)K * 2 : (size_t)0))
    Unit cur, nxt; int ui = 0;
    if (!S.next(0, cur)) return;
    f32x4 acc[2][2][4][2];
#pragma unroll
    for (int a = 0; a < 2; ++a)
#pragma unroll
        for (int b = 0; b < 2; ++b)
#pragma unroll
            for (int m = 0; m < 4; ++m)
#pragma unroll
                for (int n = 0; n < 2; ++n) acc[a][b][m][n] = (f32x4){0.f, 0.f, 0.f, 0.f};
    bf16x8 At[4][2], B0[2][2], B1[2][2];
    const char* cA = (const char*)g.A + PG8_AOFF(cur); const char* cB = (const char*)g.Bt + (size_t)cur.pn * tstepB;
    S.a_ready(cur);
    PG8_STAGE(PG8_SB(0, 0), cB, voffB); PG8_STAGE(PG8_SB(0, 1), cB + hstepB, voffB); PG8_STAGE(PG8_SA(0, 0), cA, voffA); PG8_STAGE(PG8_SA(0, 1), cA + hstepA, voffA);
    if (wr == 1) PG8_BAR;
    PG8_WAIT_V(2); PG8_BAR;
    PG8_STAGE(PG8_SB(1, 0), cB + kstep, voffB); PG8_STAGE(PG8_SA(1, 0), cA + kstep, voffA); PG8_STAGE(PG8_SB(1, 1), cB + hstepB + kstep, voffB);
    PG8_WAIT_V(6); PG8_BAR;
    for (;;) {
        const bool has_next = S.next(ui + 1, nxt);
        const char* nA = has_next ? (const char*)g.A + PG8_AOFF(nxt) : cA; const char* nB = has_next ? (const char*)g.Bt + (size_t)nxt.pn * tstepB : cB;
        for (int t = 0; t < nt; t += 2) {
            const bool last = (t == nt - 2);
            const char* a1 = cA + (size_t)(t + 1) * kstep;
            const char* a2 = last ? nA : cA + (size_t)(t + 2) * kstep; const char* b2 = last ? nB : cB + (size_t)(t + 2) * kstep;
            const char* a3 = a2 + kstep; const char* b3 = b2 + kstep;
            if (last && has_next) S.a_ready(nxt);
            PG8_LDB(B0, 0, 0); PG8_LDB(B1, 0, 1); PG8_SCHED; PG8_LDA(At, 0, 0); PG8_STAGE(PG8_SA(1, 1), a1 + hstepA, voffA);
            PG8_WAIT_V(8); PG8_WAIT_L(0); PG8_BAR; PG8_MMA(0, 0, At, B0); PG8_MMA(0, 1, At, B1); PG8_BAR; PG8_SCHED;
            PG8_LDA(At, 0, 1); PG8_STAGE(PG8_SB(0, 0), b2, voffB); PG8_STAGE(PG8_SB(0, 1), b2 + hstepB, voffB); PG8_STAGE(PG8_SA(0, 0), a2, voffA);
            PG8_WAIT_V(8); PG8_WAIT_L(0); PG8_BAR; PG8_MMA(1, 0, At, B0); PG8_MMA(1, 1, At, B1); PG8_BAR; PG8_SCHED;
            PG8_LDB(B0, 1, 0); PG8_LDB(B1, 1, 1); PG8_SCHED; PG8_LDA(At, 1, 0); PG8_STAGE(PG8_SA(0, 1), a2 + hstepA, voffA);
            PG8_WAIT_V(8); PG8_WAIT_L(0); PG8_BAR; PG8_MMA(0, 0, At, B0); PG8_MMA(0, 1, At, B1); PG8_BAR; PG8_SCHED;
            PG8_LDA(At, 1, 1); PG8_STAGE(PG8_SB(1, 0), b3, voffB); PG8_STAGE(PG8_SB(1, 1), b3 + hstepB, voffB); PG8_STAGE(PG8_SA(1, 0), a3, voffA);
            PG8_WAIT_V(8); PG8_WAIT_L(0); PG8_BAR; PG8_MMA(1, 0, At, B0); PG8_MMA(1, 1, At, B1); PG8_BAR; PG8_SCHED;
        }
        if constexpr (ALIGN_EPI) { if (wr == 0) PG8_BAR; }
        E(acc, cur, wr, wc, fr, fq); S.done(cur);
        if (!has_next) break;
#pragma unroll
        for (int a = 0; a < 2; ++a)
#pragma unroll
            for (int b = 0; b < 2; ++b)
#pragma unroll
                for (int m = 0; m < 4; ++m)
#pragma unroll
                    for (int n = 0; n < 2; ++n) acc[a][b][m][n] = (f32x4){0.f, 0.f, 0.f, 0.f};
        cur = nxt; cA = nA; cB = nB; ++ui;
        if constexpr (ALIGN_EPI) { if (wr == 1) PG8_BAR; }
    }
    PG8_WAIT_V(0);
    if constexpr (!ALIGN_EPI) { if (wr == 0) PG8_BAR; }
    PG8_BAR;
#undef PG8_SA
#undef PG8_SB
#undef PG8_STAGE
#undef PG8_LDA
#undef PG8_LDB
#undef PG8_MMA
#undef PG8_WAIT_V
#undef PG8_WAIT_L
#undef PG8_BAR
#undef PG8_SCHED
#undef PG8_AOFF
}
}

#define XB_TMO      128
#define XB_XCNT(j)  (256  + 64 * (j))
#define XB_XSUB(j)  (1280 + 64 * (j))
#define XB_XGEN(j)  (2304 + 64 * (j))
#define XB_TOP      3328
#define XB_TOPGEN   3392
#define XCD_BAR_WORDS 3456
#define XB_SPIN_CAP (1u << 18)

__device__ __forceinline__ unsigned xb_ld(unsigned* p)              { return __hip_atomic_load(p, __ATOMIC_RELAXED, __HIP_MEMORY_SCOPE_AGENT); }
__device__ __forceinline__ unsigned xb_add(unsigned* p, unsigned v) { return __hip_atomic_fetch_add(p, v, __ATOMIC_RELAXED, __HIP_MEMORY_SCOPE_AGENT); }
__device__ __forceinline__ unsigned xb_xcc_id() { return (unsigned)__builtin_amdgcn_s_getreg((3 << 11) | 20) & 0xFu; }
#define XB_SPIN(cond, bar) do { unsigned _sp = 0; while (cond) { __builtin_amdgcn_s_sleep(1); \
    if ((++_sp & 255u) == 0u) { if (xb_ld(&(bar)[XB_TMO])) break; if (_sp > XB_SPIN_CAP) { atomicAdd(&(bar)[XB_TMO], 1u); break; } } } } while (0)

struct XcdBarrier { unsigned* bar; unsigned x; volatile LAS unsigned* st; };

__device__ __forceinline__ XcdBarrier xcd_barrier_post(unsigned* bar, volatile LAS unsigned* st) {
    XcdBarrier b; b.bar = bar; b.x = xb_xcc_id(); b.st = st;
    if (threadIdx.x == 0) (void)xb_add(&bar[XB_XCNT(b.x)], 1u);
    return b;
}
__device__ __forceinline__ void xcd_barrier_complete(unsigned* bar, unsigned x, unsigned& nloc, unsigned& nx) {
    const unsigned G = gridDim.x * gridDim.y * gridDim.z;
    unsigned sum, cnt, mine, sp = 0u;
    for (;;) {
        sum = 0u; cnt = 0u; mine = 0u;
#pragma unroll
        for (unsigned j = 0; j < 16; ++j) { const unsigned c = xb_ld(&bar[XB_XCNT(j)]); sum += c; cnt += (c > 0u) ? 1u : 0u; mine = (j == x) ? c : mine; }
        if (sum == G) break;
        __builtin_amdgcn_s_sleep(1);
        if ((++sp & 255u) == 0u) { if (xb_ld(&bar[XB_TMO])) break; if (sp > XB_SPIN_CAP) { atomicAdd(&bar[XB_TMO], 1u); break; } }
    }
    nloc = mine > 0u ? mine : 1u; nx = cnt > 0u ? cnt : 1u;
}
__device__ __forceinline__ void xcd_barrier(const XcdBarrier& b) {
    asm volatile("s_waitcnt vmcnt(0)" ::: "memory");
    __syncthreads();
    if (threadIdx.x == 0) {
        unsigned* bar = b.bar;
        __builtin_amdgcn_s_waitcnt(0);
        unsigned nloc = b.st[0], nx = b.st[1];
        if (nloc == 0u) { xcd_barrier_complete(bar, b.x, nloc, nx); b.st[0] = nloc; b.st[1] = nx; }
        const unsigned old = xb_add(&bar[XB_XSUB(b.x)], 1u);
        const unsigned gen = old / nloc;
        if (old + 1u == (gen + 1u) * nloc) {
            __builtin_amdgcn_fence(__ATOMIC_RELEASE, "agent");
            asm volatile("s_waitcnt vmcnt(0)" ::: "memory");
            const unsigned og = xb_add(&bar[XB_TOP], 1u);
            const unsigned tg = og / nx;
            if (og + 1u == (tg + 1u) * nx) xb_add(&bar[XB_TOPGEN], 1u);
            else XB_SPIN(xb_ld(&bar[XB_TOPGEN]) == tg, bar);
            __builtin_amdgcn_fence(__ATOMIC_ACQUIRE, "agent");
            xb_add(&bar[XB_XGEN(b.x)], 1u);
            asm volatile("s_waitcnt vmcnt(0)" ::: "memory");
        } else {
            XB_SPIN(xb_ld(&bar[XB_XGEN(b.x)]) == gen, bar);
            __builtin_amdgcn_fence(__ATOMIC_ACQUIRE, "agent");
            asm volatile("s_waitcnt vmcnt(0)" ::: "memory");
        }
    }
    __syncthreads();
}

struct Args { const float* in[15]; float* out; unsigned char* ws; int ph_lo, ph_hi; };
struct Frame {
    LAS unsigned char* lds;
    int tid, lane, wave, vcu, G;
};
__device__ __forceinline__ float wave_sum(float v) {
#pragma unroll
    for (int o = 1; o < 64; o <<= 1) v += __shfl_xor(v, o);
    return v;
}
__device__ __forceinline__ void p0_transpose_item(const float* W, int K, int N, bf16* WT, LAS float* scr, int item, int lane) {
    const int nblk = N / 32, kb = item / nblk, nb = item % nblk, k0 = 64 * kb, n0 = 32 * nb;
#pragma unroll 8
    for (int i = 0; i < 32; ++i) { const int kk = 2 * i + (lane >> 5); scr[kk * 33 + (lane & 31)] = W[(size_t)(k0 + kk) * N + n0 + (lane & 31)]; }
    LDS_WAIT(); asm volatile("" ::: "memory");
    const int c = lane & 7;
#pragma unroll
    for (int j = 0; j < 4; ++j) { const int n = (lane >> 3) + 8 * j; const LAS float* s = scr + (8 * c) * 33 + n;
        v4u o; o.x = pk2(s[0 * 33], s[1 * 33]); o.y = pk2(s[2 * 33], s[3 * 33]); o.z = pk2(s[4 * 33], s[5 * 33]); o.w = pk2(s[6 * 33], s[7 * 33]);
        *(GAS v4u*)(WT + (size_t)(n0 + n) * K + k0 + 8 * c) = o; }
    LDS_WAIT(); asm volatile("" ::: "memory");
}

__device__ __forceinline__ void phase_prologue(Frame& F, const Args& a) {
    unsigned char* ws = a.ws;
    LAS float* scr = (LAS float*)(F.lds + F.wave * 16384);
    const int gw = F.vcu * 8 + F.wave, NGW = F.G * 8;
    constexpr int I_POOL = (1024 / 64) * (1024 / 32);
    constexpr int I_WIN = (DM / 64) * (PW / 32);
    constexpr int I_WOUT = (VD / 64) * (DM / 32);
    constexpr int I_W1 = (DM / 64) * (FF / 32);
    constexpr int I_W2 = (FF / 64) * (DM / 32);
    constexpr int NITEMS = 4 * I_POOL + I_WIN + I_WOUT + 2 * I_W1 + 2 * I_W2;
    for (int it = gw; it < NITEMS; it += NGW) {
        int r = it;
        if (r < 4 * I_POOL) { const int g = r / I_POOL; p0_transpose_item(a.in[4] + (size_t)g * 1024 * 1024, 1024, 1024, (bf16*)(ws + WS_WPOOL) + (size_t)g * 1024 * 1024, scr, r % I_POOL, F.lane); continue; } r -= 4 * I_POOL;
        if (r < I_WIN) { p0_transpose_item(a.in[6], DM, PW, (bf16*)(ws + WS_WIN), scr, r, F.lane); continue; } r -= I_WIN;
        if (r < I_WOUT) { p0_transpose_item(a.in[12], VD, DM, (bf16*)(ws + WS_WOUT), scr, r, F.lane); continue; } r -= I_WOUT;
        if (r < 2 * I_W1) { const int l = r / I_W1; p0_transpose_item(a.in[13] + (size_t)l * DM * FF, DM, FF, (bf16*)(ws + WS_W1) + (size_t)l * DM * FF, scr, r % I_W1, F.lane); continue; } r -= 2 * I_W1;
        { const int l = r / I_W2; p0_transpose_item(a.in[14] + (size_t)l * DM * FF, FF, DM, (bf16*)(ws + WS_W2) + (size_t)l * DM * FF, scr, r % I_W2, F.lane); }
    }
    { GAS v4u* z = (GAS v4u*)((bf16*)(ws + WS_WIN) + (size_t)PW * DM); const int nz = (PWP - PW) * DM / 8;
      for (int i = gw * 64 + F.lane; i < nz; i += NGW * 64) z[i] = (v4u){0u, 0u, 0u, 0u}; }
    const float* x = a.in[0]; float* rstd0 = (float*)(ws + WS_RSTD0);
    for (int m = gw; m < M; m += NGW) {
        const GAS f32x4* xr = (const GAS f32x4*)(x + (size_t)m * DM) + F.lane; float s = 0.f;
#pragma unroll
        for (int j = 0; j < 16; ++j) { const f32x4 v = xr[64 * j]; s += (v.x * v.x + v.y * v.y) + (v.z * v.z + v.w * v.w); }
        s = wave_sum(s);
        if (F.lane == 0) rstd0[m] = 1.0f / sqrtf(s * (1.0f / DM) + EPS);
    }
}

__device__ __forceinline__ void phase_pooldiff(Frame& F, const Args& a) {
    const float* x = a.in[0]; const float* gmix = a.in[1]; const float* rstd0 = (const float*)(a.ws + WS_RSTD0); bf16* D = (bf16*)(a.ws + WS_D);
    for (int it = F.vcu; it < 1024; it += F.G) {
        const int half = it & 1, run = (it >> 1) & 63, b = it >> 7;
        const int c = half * 2048 + F.tid * 4, grp = c >> 10, wh = 1 << grp, t0 = run * 32;
        const f32x4 gv = *(const f32x4*)(gmix + c);
        const float* xb = x + (size_t)b * SEQ * DM + c; const float* rb = rstd0 + b * SEQ;
        f32x4 s = {0.f, 0.f, 0.f, 0.f};
        const int lo0 = (t0 - wh) > 0 ? (t0 - wh) : 0, hi0 = (t0 + wh) < SEQ ? (t0 + wh) : SEQ;
        for (int u = lo0; u < hi0; ++u) s += *(const f32x4*)(xb + (size_t)u * DM) * rb[u];
        for (int t = t0; t < t0 + 32; ++t) {
            const int lo = (t - wh) > 0 ? (t - wh) : 0, hi = (t + wh) < SEQ ? (t + wh) : SEQ;
            const float inv = 1.0f / (float)(hi - lo);
            const f32x4 cen = *(const f32x4*)(xb + (size_t)t * DM) * rb[t];
            const f32x4 d = (s * inv - cen) * gv;
            v2u w; w.x = pk2(d.x, d.y); w.y = pk2(d.z, d.w);
            *(v2u*)(D + ((size_t)(b * SEQ + t)) * DM + c) = w;
            if (t + wh < SEQ) s += *(const f32x4*)(xb + (size_t)(t + wh) * DM) * rb[t + wh];
            if (t - wh >= 0) s -= *(const f32x4*)(xb + (size_t)(t - wh) * DM) * rb[t - wh];
        }
    }
}

__device__ __forceinline__ void phase_gla_decay(Frame& F, const Args& a) {
    const float* R = (const float*)(a.ws + WS_R); float* AD = (float*)(a.ws + WS_AD);
    for (int it = F.vcu; it < 2 * (M / 8); it += F.G) {
        const int dir = it / (M / 8), tb = it % (M / 8);
        const float* wup = a.in[dir ? 9 : 7]; const float* bup = a.in[dir ? 10 : 8];
        for (int j = 0; j < 4; ++j) {
            const int dk = F.tid + 512 * j; float w[16];
#pragma unroll
            for (int r = 0; r < 16; ++r) w[r] = wup[r * KD + dk];
            const float bias = bup[dk];
            for (int t = 0; t < 8; ++t) {
                const int tok = tb * 8 + t; const float* rr = R + (size_t)tok * 32 + dir * 16; float xacc = bias;
#pragma unroll
                for (int r = 0; r < 16; ++r) xacc += rr[r] * w[r];
                const float ls = fminf(xacc, 0.f) - log1pf(__expf(-fabsf(xacc)));
                AD[((size_t)dir * M + tok) * KD + dk] = __expf(ls * (1.0f / 16.0f));
            }
        }
    }
}
__device__ __forceinline__ void phase_gla_recur(Frame& F, const Args& a) {
    const bf16* Qb = (const bf16*)(a.ws + WS_Q); const bf16* Kb = (const bf16*)(a.ws + WS_K); const bf16* Vb = (const bf16*)(a.ws + WS_V);
    const float* AD = (const float*)(a.ws + WS_AD); float* O = (float*)(a.ws + WS_O);
    constexpr int TB = 8, QS = 132;
    LAS float* qs = (LAS float*)F.lds;
    LAS float* ks = qs + TB * 4 * QS;
    LAS float* as = ks + TB * 4 * QS;
    LAS float* vs = as + TB * 4 * QS;
    const int dvl = F.tid >> 2, qt = F.tid & 3;
    const float qscale = 0.044194173824159216f;
    for (int it = F.vcu; it < BATCH * NH * 8; it += F.G) {
        const int blk = it & 7, h = (it >> 3) & 3, b = it >> 5;
        for (int dir = 0; dir < 2; ++dir) {
            float S[128];
#pragma unroll
            for (int i = 0; i < 128; ++i) S[i] = 0.f;
            for (int tb = 0; tb < SEQ / TB; ++tb) {
                __syncthreads();
#pragma unroll
                for (int e = 0; e < 8; ++e) {
                    const int idx = F.tid + 512 * e, tt = idx >> 9, dk = idx & 511;
                    const int sp = tb * TB + tt, tok = b * SEQ + (dir ? (SEQ - 1 - sp) : sp);
                    const int li = tt * 4 * QS + (dk >> 7) * QS + (dk & 127);
                    qs[li] = bf2f(Qb[(size_t)tok * KD + h * HK + dk]) * qscale;
                    ks[li] = bf2f(Kb[(size_t)tok * KD + h * HK + dk]);
                    as[li] = AD[((size_t)dir * M + tok) * KD + h * HK + dk];
                }
#pragma unroll
                for (int e = 0; e < 2; ++e) {
                    const int idx = F.tid + 512 * e, tt = idx >> 7, dv = idx & 127;
                    const int sp = tb * TB + tt, tok = b * SEQ + (dir ? (SEQ - 1 - sp) : sp);
                    vs[tt * 128 + dv] = bf2f(Vb[(size_t)tok * VD + h * HV + blk * 128 + dv]);
                }
                __syncthreads();
                for (int tt = 0; tt < TB; ++tt) {
                    const float v = vs[tt * 128 + dvl]; float o = 0.f;
                    const LAS float* qp = qs + tt * 4 * QS + qt * QS; const LAS float* kp = ks + tt * 4 * QS + qt * QS; const LAS float* ap = as + tt * 4 * QS + qt * QS;
#pragma unroll
                    for (int i = 0; i < 128; i += 4) {
                        const f32x4 q4 = *(const LAS f32x4*)(qp + i), k4 = *(const LAS f32x4*)(kp + i), a4 = *(const LAS f32x4*)(ap + i);
#pragma unroll
                        for (int j = 0; j < 4; ++j) { S[i + j] = a4[j] * S[i + j] + k4[j] * v; o += q4[j] * S[i + j]; }
                    }
                    o += __shfl_xor(o, 1); o += __shfl_xor(o, 2);
                    if (qt == 0) {
                        const int sp = tb * TB + tt, tok = b * SEQ + (dir ? (SEQ - 1 - sp) : sp);
                        float* op = O + (size_t)tok * VD + h * HV + blk * 128 + dvl;
                        if (dir) *op = *op + o; else *op = o;
                    }
                }
            }
        }
    }
}

__device__ __forceinline__ void phase_post(Frame& F, const Args& a) {
    const float* O = (const float*)(a.ws + WS_O); const bf16* Gt = (const bf16*)(a.ws + WS_G); bf16* XA = (bf16*)(a.ws + WS_D); const float* gn = a.in[11];
    const int gw = F.vcu * 8 + F.wave, NGW = F.G * 8;
    f32x4 gv[4];
#pragma unroll
    for (int j = 0; j < 4; ++j) gv[j] = *(const f32x4*)(gn + F.lane * 4 + 256 * j);
    for (int it = gw; it < M * NH; it += NGW) {
        const size_t base = (size_t)(it >> 2) * VD + (it & 3) * HV + F.lane * 4;
        f32x4 o[4]; float s = 0.f;
#pragma unroll
        for (int j = 0; j < 4; ++j) { o[j] = *(const f32x4*)(O + base + 256 * j); s += (o[j].x * o[j].x + o[j].y * o[j].y) + (o[j].z * o[j].z + o[j].w * o[j].w); }
        s = wave_sum(s); const float rs = 1.0f / sqrtf(s * (1.0f / HV) + EPS);
#pragma unroll
        for (int j = 0; j < 4; ++j) {
            const v2u gw2 = *(const v2u*)(Gt + base + 256 * j);
            const float g0 = bf2f((unsigned short)(gw2.x & 0xffffu)), g1 = bf2f((unsigned short)(gw2.x >> 16)), g2 = bf2f((unsigned short)(gw2.y & 0xffffu)), g3 = bf2f((unsigned short)(gw2.y >> 16));
            const f32x4 y = o[j] * rs * gv[j];
            const float r0 = y.x * g0 / (1.0f + __expf(-g0)), r1 = y.y * g1 / (1.0f + __expf(-g1)), r2 = y.z * g2 / (1.0f + __expf(-g2)), r3 = y.w * g3 / (1.0f + __expf(-g3));
            v2u w; w.x = pk2(r0, r1); w.y = pk2(r2, r3);
            *(v2u*)(XA + base + 256 * j) = w;
        }
    }
}
__device__ __forceinline__ void phase_final(Frame& F, const Args& a) {
    float* H = a.out; const float* ss = (const float*)(a.ws + WS_CTL) + CW_SS + 3 * M; const float* gf = a.in[3];
    const int gw = F.vcu * 8 + F.wave, NGW = F.G * 8;
    for (int m = gw; m < M; m += NGW) {
        const float rs = 1.0f / sqrtf(ld_agent(ss + m) * (1.0f / DM) + EPS);
        f32x4* hr = (f32x4*)(H + (size_t)m * DM) + F.lane;
#pragma unroll
        for (int j = 0; j < 16; ++j) { const f32x4 g = *((const f32x4*)gf + F.lane + 64 * j); hr[64 * j] = hr[64 * j] * rs * g; }
    }
}

__global__ void __launch_bounds__(512, 2) mk_fwd(Args args) {
    extern __shared__ __attribute__((aligned(16))) unsigned char lds[];
    Frame F;
    F.lds = (LAS unsigned char*)lds;
    F.tid = threadIdx.x; F.lane = F.tid & 63; F.wave = __builtin_amdgcn_readfirstlane(F.tid >> 6);
    F.G = gridDim.x; { const int bx = blockIdx.x; F.vcu = (F.G % 8 == 0) ? (bx % 8) * (F.G / 8) + bx / 8 : bx; }
    volatile LAS unsigned* MISC = (volatile LAS unsigned*)(F.lds + MISC_OFF);
    if (F.tid < 64) MISC[F.tid] = 0u;
    __syncthreads();
    unsigned char* ws = args.ws;
    unsigned* ctl = (unsigned*)(ws + WS_CTL);
    const int lo = args.ph_lo, hi = args.ph_hi;
    XcdBarrier bar; bar.bar = ctl + CW_BAR; bar.x = 0; bar.st = nullptr;
    if (hi - lo > 1) bar = xcd_barrier_post(ctl + CW_BAR, MISC + 8);
#define IN(k) (lo <= (k) && (k) < hi)
#define SEAM(k) do { if (IN(k) && IN((k) + 1)) xcd_barrier(bar); } while (0)
    float* SS = (float*)ctl + CW_SS;
    float* H = args.out;
    bf16* XN = (bf16*)(ws + WS_XN); bf16* Db = (bf16*)(ws + WS_D); bf16* HID = (bf16*)(ws + WS_HID);
    const float* norm_mix = args.in[1]; const float* norm_mlp = args.in[2];

    if (IN(0)) { phase_prologue(F, args); } SEAM(0);
    if (IN(1)) { phase_pooldiff(F, args); } SEAM(1);
    if (IN(2)) {
        pg8::Gemm g{Db, (const bf16*)(ws + WS_WPOOL), M, DM, 1024, DM, 4}; pg8::StaticOrder S; S.init(M, DM, F.G, (int)blockIdx.x);
        pg8::EpiResid E{args.in[0], H, args.in[5], norm_mlp, XN, SS + 0 * M, DM};
        pg8::gemm_phase<pg8::EpiResid, pg8::StaticOrder>(F.lds, g, S, E);
    } SEAM(2);
    if (IN(3)) {
        pg8::Gemm g{XN, (const bf16*)(ws + WS_W1), M, FF, DM, DM, 0}; pg8::StaticOrder S; S.init(M, FF, F.G, (int)blockIdx.x);
        pg8::EpiRelu2 E{HID, FF, SS + 0 * M};
        pg8::gemm_phase<pg8::EpiRelu2, pg8::StaticOrder>(F.lds, g, S, E);
    } SEAM(3);
    if (IN(4)) {
        pg8::Gemm g{HID, (const bf16*)(ws + WS_W2), M, DM, FF, FF, 0}; pg8::StaticOrder S; S.init(M, DM, F.G, (int)blockIdx.x);
        pg8::EpiResid E{H, H, nullptr, norm_mix + DM, XN, SS + 1 * M, DM};
        pg8::gemm_phase<pg8::EpiResid, pg8::StaticOrder>(F.lds, g, S, E);
    } SEAM(4);
    if (IN(5)) {
        pg8::Gemm g{XN, (const bf16*)(ws + WS_WIN), M, PWP, DM, DM, 0}; pg8::StaticOrder S; S.init(M, PWP, F.G, (int)blockIdx.x);
        pg8::EpiInProj E{(bf16*)(ws + WS_Q), (bf16*)(ws + WS_K), (bf16*)(ws + WS_V), (bf16*)(ws + WS_G), (float*)(ws + WS_R), SS + 1 * M};
        pg8::gemm_phase<pg8::EpiInProj, pg8::StaticOrder>(F.lds, g, S, E);
    } SEAM(5);
    if (IN(6)) { phase_gla_decay(F, args); } SEAM(6);
    if (IN(7)) { phase_gla_recur(F, args); } SEAM(7);
    if (IN(8)) { phase_post(F, args); } SEAM(8);
    if (IN(9)) {
        pg8::Gemm g{Db, (const bf16*)(ws + WS_WOUT), M, DM, VD, VD, 0}; pg8::StaticOrder S; S.init(M, DM, F.G, (int)blockIdx.x);
        pg8::EpiResid E{H, H, nullptr, norm_mlp + DM, XN, SS + 2 * M, DM};
        pg8::gemm_phase<pg8::EpiResid, pg8::StaticOrder>(F.lds, g, S, E);
    } SEAM(9);
    if (IN(10)) {
        pg8::Gemm g{XN, (const bf16*)(ws + WS_W1) + (size_t)DM * FF, M, FF, DM, DM, 0}; pg8::StaticOrder S; S.init(M, FF, F.G, (int)blockIdx.x);
        pg8::EpiRelu2 E{HID, FF, SS + 2 * M};
        pg8::gemm_phase<pg8::EpiRelu2, pg8::StaticOrder>(F.lds, g, S, E);
    } SEAM(10);
    if (IN(11)) {
        pg8::Gemm g{HID, (const bf16*)(ws + WS_W2) + (size_t)DM * FF, M, DM, FF, FF, 0}; pg8::StaticOrder S; S.init(M, DM, F.G, (int)blockIdx.x);
        pg8::EpiResid E{H, H, nullptr, nullptr, nullptr, SS + 3 * M, DM};
        pg8::gemm_phase<pg8::EpiResid, pg8::StaticOrder>(F.lds, g, S, E);
    } SEAM(11);
    if (IN(12)) { phase_final(F, args); }
#undef IN
#undef SEAM
}

extern "C" void kernel_launch(void* const* d_in, const int* in_sizes, int n_in, void* d_out, int out_size, void* d_ws, size_t ws_size, hipStream_t stream) {
    static int grid = 0;
    if (grid == 0) {
        if (n_in != 15 || in_sizes[0] != M * DM || out_size != M * DM || ws_size < WS_END) {
            fprintf(stderr, "kernel_launch: unexpected problem (n_in %d, in0 %d, out %d, ws %zu < %zu); nothing launched\n", n_in, n_in > 0 ? in_sizes[0] : -1, out_size, ws_size, (size_t)WS_END); grid = -1; return; }
        int dev = 0, cus = 0;
        if (hipGetDevice(&dev) != hipSuccess || hipDeviceGetAttribute(&cus, hipDeviceAttributeMultiprocessorCount, dev) != hipSuccess) { grid = -1; return; }
        if (hipFuncSetAttribute((const void*)mk_fwd, hipFuncAttributeMaxDynamicSharedMemorySize, LDS_BYTES) != hipSuccess) { fprintf(stderr, "kernel_launch: hipFuncSetAttribute failed\n"); grid = -1; return; }
        int per_cu = 0;
        if (hipOccupancyMaxActiveBlocksPerMultiprocessor(&per_cu, (const void*)mk_fwd, 512, LDS_BYTES) != hipSuccess || per_cu < 1) fprintf(stderr, "kernel_launch: occupancy query says %d\n", per_cu);
        (void)hipGetLastError();
        grid = cus;
    }
    if (grid < 0) return;
    (void)hipMemsetAsync((char*)d_ws + WS_CTL, 0, CTL_ZERO_BYTES, stream);
    Args a{};
    for (int i = 0; i < 15; ++i) a.in[i] = (const float*)d_in[i];
    a.out = (float*)d_out; a.ws = (unsigned char*)d_ws;
#if MK_PER_PHASE
    for (int p = 0; p < NPHASE; ++p) { a.ph_lo = p; a.ph_hi = p + 1; hipLaunchKernelGGL(mk_fwd, dim3(grid), dim3(512), LDS_BYTES, stream, a); }
#else
    a.ph_lo = 0; a.ph_hi = NPHASE; hipLaunchKernelGGL(mk_fwd, dim3(grid), dim3(512), LDS_BYTES, stream, a);
#endif
}
```

```cpp
#include <hip/hip_runtime.h>
#include <cstdio>
#include <cstdint>

#ifndef MK_PER_PHASE
#define MK_PER_PHASE 0
#endif

constexpr int BATCH = 8, SEQ = 2048, DM = 4096, M = BATCH * SEQ, FF = 4 * DM;
constexpr int NH = 4, KD = DM / 2, VD = DM, HK = KD / NH, HV = VD / NH, GR = 16;
constexpr int PW = 2 * KD + 2 * VD + 2 * GR;
constexpr int PWP = 12544;
constexpr float EPS = 1e-6f;
constexpr int NPHASE = 13;

constexpr size_t MiB = 1u << 20;
constexpr size_t WS_CTL = 0, CTL_ZERO_BYTES = 1 * MiB;
constexpr size_t WS_WPOOL = 2 * MiB;
constexpr size_t WS_WOUT = 10 * MiB;
constexpr size_t WS_WIN = 42 * MiB;
constexpr size_t WS_W1 = 140 * MiB;
constexpr size_t WS_W2 = 396 * MiB;
constexpr size_t WS_XN = 652 * MiB;
constexpr size_t WS_D = 780 * MiB;
constexpr size_t WS_HID = 908 * MiB;
constexpr size_t WS_Q = 908 * MiB;
constexpr size_t WS_K = 972 * MiB;
constexpr size_t WS_V = 1036 * MiB;
constexpr size_t WS_G = 1164 * MiB;
constexpr size_t WS_R = 1292 * MiB;
constexpr size_t WS_AD = 1294 * MiB;
constexpr size_t WS_O = 1550 * MiB;
constexpr size_t WS_RSTD0 = 1806 * MiB;
constexpr size_t WS_END = 1807 * MiB;
constexpr int CW_BAR = 4096;
constexpr int CW_SS = 131072;

constexpr int LDS_BYTES = 159 * 1024;
constexpr int RING_BYTES = 131072;
constexpr int MISC_OFF = LDS_BYTES - 256;

#define GAS __attribute__((address_space(1)))
#define LAS __attribute__((address_space(3)))
typedef unsigned short bf16;
typedef unsigned v4u __attribute__((ext_vector_type(4)));
typedef unsigned v2u __attribute__((ext_vector_type(2)));
typedef float f32x4 __attribute__((ext_vector_type(4)));
typedef short bf16x8 __attribute__((ext_vector_type(8)));
#define LDS_WAIT() asm volatile("s_waitcnt lgkmcnt(0)" ::: "memory")
#define VM_WAIT() asm volatile("s_waitcnt vmcnt(0)" ::: "memory")
__device__ __forceinline__ unsigned f2bf(float f) { unsigned u = __builtin_bit_cast(unsigned, f); return (u + 0x7fffu + ((u >> 16) & 1u)) >> 16; }
__device__ __forceinline__ unsigned pk2(float lo, float hi) { return f2bf(lo) | (f2bf(hi) << 16); }
__device__ __forceinline__ float bf2f(unsigned short b) { return __builtin_bit_cast(float, ((unsigned)b) << 16); }
__device__ __forceinline__ float ld_agent(const float* p) { return __builtin_bit_cast(float, __hip_atomic_load((const unsigned*)p, __ATOMIC_RELAXED, __HIP_MEMORY_SCOPE_AGENT)); }

namespace pg8 {
#define PG8_LAS __attribute__((address_space(3)))
typedef unsigned short bf16_t;
typedef unsigned u32x4 __attribute__((ext_vector_type(4)));
constexpr int BM = 256, BK = 64, HALF = 128, HTB = HALF * BK * 2, STAGE_BYTES = 8 * HTB, NXCD = 8, WGM = 8;

__host__ __device__ __forceinline__ int lds_byte(int r, int c) { const int st = (r >> 4) * 2 + (c >> 5), rr = r & 15, cc = c & 31, ob = rr * 64 + cc * 2; return st * 1024 + (ob ^ (((ob >> 9) & 1) << 5)); }
__host__ __device__ __forceinline__ void stage_rc(int b, int& R, int& C) { const int st = b / 1024, sb = b % 1024, swz = sb ^ (((sb >> 9) & 1) << 5); R = (st >> 1) * 16 + swz / 64; C = (st & 1) * 32 + (swz % 64) / 2; }
__host__ __device__ __forceinline__ int perm32(int rho) { const int n = rho >> 4, i = rho & 15; return 8 * (i >> 2) + 4 * n + (i & 3); }

struct Unit { int pm, pn; };
struct Gemm { const bf16_t* A; const bf16_t* Bt; int M, N, K, lda, grp; };

struct StaticOrder {
    int nM, nN, nwg, G, c;
    __host__ __device__ void init(int M_, int N_, int G_, int c_) { nM = M_ / BM; nN = N_ / BM; nwg = nM * nN; G = G_; c = c_; }
    __host__ __device__ bool next(int i, Unit& u) const {
        const long L = (long)i * G + c; if (L >= nwg) return false;
        int wgid = (int)L; { const int q = nwg / NXCD, r = nwg % NXCD, xcd = wgid % NXCD, off = wgid / NXCD; wgid = (xcd < r ? xcd * (q + 1) : r * (q + 1) + (xcd - r) * q) + off; }
        const int nig = WGM * nN, gid = wgid / nig, fm = gid * WGM, gsz = (nM - fm) < WGM ? (nM - fm) : WGM;
        u.pm = fm + ((wgid % nig) % gsz); u.pn = (wgid % nig) / gsz; return true;
    }
    __device__ __forceinline__ void a_ready(const Unit&) const {}
    __device__ __forceinline__ void done(const Unit&) const {}
};

__device__ __forceinline__ unsigned cvt_pk_bf16(float lo, float hi) { unsigned r; asm volatile("v_cvt_pk_bf16_f32 %0, %1, %2" : "=v"(r) : "v"(lo), "v"(hi)); return r; }


struct EpiResid {
    static constexpr bool PERM = true, AFTER_DRAIN = false;
    const float* hin; float* hout; const float* cscale; const float* gnext; bf16_t* xn; float* ss; int ldc;
    __device__ __forceinline__ void operator()(const f32x4 (&acc)[2][2][4][2], const Unit& u, int wr, int wc, int fr, int fq) const {
        const int row0 = u.pm * BM + wr * 64 + fr, col0 = u.pn * BM + wc * 32 + 8 * fq;
        f32x4 sc[2][2], gn[2][2];
#pragma unroll
        for (int bj = 0; bj < 2; ++bj)
#pragma unroll
            for (int n = 0; n < 2; ++n) {
                sc[bj][n] = cscale ? *(const f32x4*)(cscale + col0 + bj * HALF + 4 * n) : (f32x4){1.f, 1.f, 1.f, 1.f};
                gn[bj][n] = gnext ? *(const f32x4*)(gnext + col0 + bj * HALF + 4 * n) : (f32x4){1.f, 1.f, 1.f, 1.f};
            }
#pragma unroll
        for (int ai = 0; ai < 2; ++ai)
#pragma unroll
            for (int m = 0; m < 4; ++m) {
                const int r = row0 + ai * HALF + m * 16; const size_t off = (size_t)r * ldc + col0; float s = 0.f;
#pragma unroll
                for (int bj = 0; bj < 2; ++bj) {
                    const f32x4 h0 = *(const f32x4*)(hin + off + bj * HALF), h1 = *(const f32x4*)(hin + off + bj * HALF + 4);
                    const f32x4 v0 = h0 + acc[ai][bj][m][0] * sc[bj][0], v1 = h1 + acc[ai][bj][m][1] * sc[bj][1];
                    *(f32x4*)(hout + off + bj * HALF) = v0; *(f32x4*)(hout + off + bj * HALF + 4) = v1;
                    s += (v0[0] * v0[0] + v0[1] * v0[1]) + (v0[2] * v0[2] + v0[3] * v0[3]) + (v1[0] * v1[0] + v1[1] * v1[1]) + (v1[2] * v1[2] + v1[3] * v1[3]);
                    if (xn) { const f32x4 a = v0 * gn[bj][0], b = v1 * gn[bj][1]; u32x4 w; w.x = cvt_pk_bf16(a[0], a[1]); w.y = cvt_pk_bf16(a[2], a[3]); w.z = cvt_pk_bf16(b[0], b[1]); w.w = cvt_pk_bf16(b[2], b[3]);
                        *(u32x4*)(xn + off + bj * HALF) = w; }
                }
                s += __shfl_xor(s, 16); s += __shfl_xor(s, 32);
                if (fq == 0) unsafeAtomicAdd(ss + r, s);
                asm volatile("" ::: "memory");
            }
    }
};
struct EpiRelu2 {
    static constexpr bool PERM = true, AFTER_DRAIN = false;
    bf16_t* O; int ldc; const float* ss;
    __device__ __forceinline__ void operator()(const f32x4 (&acc)[2][2][4][2], const Unit& u, int wr, int wc, int fr, int fq) const {
        const int row0 = u.pm * BM + wr * 64 + fr, col0 = u.pn * BM + wc * 32 + 8 * fq;
#pragma unroll
        for (int ai = 0; ai < 2; ++ai)
#pragma unroll
            for (int m = 0; m < 4; ++m) {
                const int r = row0 + ai * HALF + m * 16; const float rs = 1.0f / sqrtf(ld_agent(ss + r) * (1.0f / DM) + EPS);
                bf16_t* rowp = O + (size_t)r * ldc + col0;
#pragma unroll
                for (int bj = 0; bj < 2; ++bj) { f32x4 v0 = acc[ai][bj][m][0] * rs, v1 = acc[ai][bj][m][1] * rs;
#pragma unroll
                    for (int j = 0; j < 4; ++j) { const float a = fmaxf(v0[j], 0.f), b = fmaxf(v1[j], 0.f); v0[j] = a * a; v1[j] = b * b; }
                    u32x4 w; w.x = cvt_pk_bf16(v0[0], v0[1]); w.y = cvt_pk_bf16(v0[2], v0[3]); w.z = cvt_pk_bf16(v1[0], v1[1]); w.w = cvt_pk_bf16(v1[2], v1[3]);
                    *(u32x4*)(rowp + bj * HALF) = w; }
            }
    }
};
struct EpiInProj {
    static constexpr bool PERM = true, AFTER_DRAIN = false;
    bf16_t *Q, *K, *V, *G; float* R; const float* ss;
    __device__ __forceinline__ void operator()(const f32x4 (&acc)[2][2][4][2], const Unit& u, int wr, int wc, int fr, int fq) const {
        const int row0 = u.pm * BM + wr * 64 + fr; const int pn = u.pn;
        bf16_t* base; int ldc, colt;
        if (pn < 8) { base = Q; ldc = KD; colt = pn * BM; } else if (pn < 16) { base = K; ldc = KD; colt = (pn - 8) * BM; }
        else if (pn < 32) { base = V; ldc = VD; colt = (pn - 16) * BM; } else { base = G; ldc = VD; colt = (pn - 32) * BM; }
        const int col0 = colt + wc * 32 + 8 * fq;
#pragma unroll
        for (int ai = 0; ai < 2; ++ai)
#pragma unroll
            for (int m = 0; m < 4; ++m) {
                const int r = row0 + ai * HALF + m * 16; const float rs = 1.0f / sqrtf(ld_agent(ss + r) * (1.0f / DM) + EPS);
                if (pn < 48) {
                    bf16_t* rowp = base + (size_t)r * ldc + col0;
#pragma unroll
                    for (int bj = 0; bj < 2; ++bj) { const f32x4 v0 = acc[ai][bj][m][0] * rs, v1 = acc[ai][bj][m][1] * rs;
                        u32x4 w; w.x = cvt_pk_bf16(v0[0], v0[1]); w.y = cvt_pk_bf16(v0[2], v0[3]); w.z = cvt_pk_bf16(v1[0], v1[1]); w.w = cvt_pk_bf16(v1[2], v1[3]);
                        *(u32x4*)(rowp + bj * HALF) = w; }
                } else if (wc == 0) {
                    float* rp = R + (size_t)r * 32 + 8 * fq;
                    *(f32x4*)rp = acc[ai][0][m][0] * rs; *(f32x4*)(rp + 4) = acc[ai][0][m][1] * rs;
                }
            }
    }
};

template <class Epi, class Sched, bool ALIGN_EPI = true>
__device__ __forceinline__ void gemm_phase(PG8_LAS unsigned char* lds, const Gemm g, const Sched& S, const Epi& E) {
    const int tid = threadIdx.x, wid = __builtin_amdgcn_readfirstlane(tid >> 6), lane = tid & 63, wr = wid >> 2, wc = wid & 3, fr = lane & 15, fq = lane >> 4;
    const int K = g.K, nt = K / BK, lda = g.lda;
    unsigned voffA[2], voffB[2];
#pragma unroll
    for (int i = 0; i < 2; ++i) { int R, C; stage_rc(tid * 16 + i * 8192, R, C); const int Rb = Epi::PERM ? ((R & ~31) + perm32(R & 31)) : R;
        voffA[i] = (unsigned)(R * lda + C) * 2u; voffB[i] = (unsigned)(Rb * K + C) * 2u; }
    const size_t kstep = (size_t)(BK * 2);
    const size_t hstepA = (size_t)HALF * lda * 2, hstepB = (size_t)HALF * K * 2;
    const size_t tstepA = 2 * hstepA, tstepB = 2 * hstepB;
    const unsigned ldsw = (unsigned)wid * 1024u;
    const int aoff = lds_byte(wr * 64 + fr, fq * 8), boff = lds_byte(wc * 32 + fr, fq * 8);
#define PG8_SA(b, h) (((b) * 2 + (h)) * HTB)
#define PG8_SB(b, h) ((4 + (b) * 2 + (h)) * HTB)
#define PG8_STAGE(bufoff, gbase, voff) do { _Pragma("unroll") for (int _i = 0; _i < 2; ++_i) \
        __builtin_amdgcn_global_load_lds((const unsigned*)((const char*)(gbase) + (voff)[_i]), (PG8_LAS unsigned*)(lds + (bufoff) + ldsw + _i * 8192), 16, 0, 0); } while (0)
#define PG8_LDA(dst, b, h) do { _Pragma("unroll") for (int m = 0; m < 4; ++m) _Pragma("unroll") for (int k = 0; k < 2; ++k) dst[m][k] = *(const PG8_LAS bf16x8*)(lds + PG8_SA(b, h) + aoff + m * 2048 + k * 1024); } while (0)
#define PG8_LDB(dst, b, h) do { _Pragma("unroll") for (int n = 0; n < 2; ++n) _Pragma("unroll") for (int k = 0; k < 2; ++k) dst[n][k] = *(const PG8_LAS bf16x8*)(lds + PG8_SB(b, h) + boff + n * 2048 + k * 1024); } while (0)
#define PG8_MMA(ai, bj, At, Bt) do { __builtin_amdgcn_s_setprio(1); _Pragma("unroll") for (int m = 0; m < 4; ++m) _Pragma("unroll") for (int n = 0; n < 2; ++n) _Pragma("unroll") for (int k = 0; k < 2; ++k) \
        acc[ai][bj][m][n] = __builtin_amdgcn_mfma_f32_16x16x32_bf16(Bt[n][k], At[m][k], acc[ai][bj][m][n], 0, 0, 0); __builtin_amdgcn_s_setprio(0); } while (0)
#define PG8_WAIT_V(n) asm volatile("s_waitcnt vmcnt(" #n ")" ::: "memory")
#define PG8_WAIT_L(n) asm volatile("s_waitcnt lgkmcnt(" #n ")" ::: "memory")
#define PG8_BAR __builtin_amdgcn_s_barrier()
#define PG8_SCHED __builtin_amdgcn_sched_barrier(0)
#define PG8_AOFF(u) ((size_t)(u).pm * tstepA + (g.grp ? (size_t)((u).pn / g.grp) * (size_t)K * 2 : (size_t)0))
    Unit cur, nxt; int ui = 0;
    if (!S.next(0, cur)) return;
    f32x4 acc[2][2][4][2];
#pragma unroll
    for (int a = 0; a < 2; ++a)
#pragma unroll
        for (int b = 0; b < 2; ++b)
#pragma unroll
            for (int m = 0; m < 4; ++m)
#pragma unroll
                for (int n = 0; n < 2; ++n) acc[a][b][m][n] = (f32x4){0.f, 0.f, 0.f, 0.f};
    bf16x8 At[4][2], B0[2][2], B1[2][2];
    const char* cA = (const char*)g.A + PG8_AOFF(cur); const char* cB = (const char*)g.Bt + (size_t)cur.pn * tstepB;
    S.a_ready(cur);
    PG8_STAGE(PG8_SB(0, 0), cB, voffB); PG8_STAGE(PG8_SB(0, 1), cB + hstepB, voffB); PG8_STAGE(PG8_SA(0, 0), cA, voffA); PG8_STAGE(PG8_SA(0, 1), cA + hstepA, voffA);
    if (wr == 1) PG8_BAR;
    PG8_WAIT_V(2); PG8_BAR;
    PG8_STAGE(PG8_SB(1, 0), cB + kstep, voffB); PG8_STAGE(PG8_SA(1, 0), cA + kstep, voffA); PG8_STAGE(PG8_SB(1, 1), cB + hstepB + kstep, voffB);
    PG8_WAIT_V(6); PG8_BAR;
    for (;;) {
        const bool has_next = S.next(ui + 1, nxt);
        const char* nA = has_next ? (const char*)g.A + PG8_AOFF(nxt) : cA; const char* nB = has_next ? (const char*)g.Bt + (size_t)nxt.pn * tstepB : cB;
        for (int t = 0; t < nt; t += 2) {
            const bool last = (t == nt - 2);
            const char* a1 = cA + (size_t)(t + 1) * kstep;
            const char* a2 = last ? nA : cA + (size_t)(t + 2) * kstep; const char* b2 = last ? nB : cB + (size_t)(t + 2) * kstep;
            const char* a3 = a2 + kstep; const char* b3 = b2 + kstep;
            if (last && has_next) S.a_ready(nxt);
            PG8_LDB(B0, 0, 0); PG8_LDB(B1, 0, 1); PG8_SCHED; PG8_LDA(At, 0, 0); PG8_STAGE(PG8_SA(1, 1), a1 + hstepA, voffA);
            PG8_WAIT_V(8); PG8_WAIT_L(0); PG8_BAR; PG8_MMA(0, 0, At, B0); PG8_MMA(0, 1, At, B1); PG8_BAR; PG8_SCHED;
            PG8_LDA(At, 0, 1); PG8_STAGE(PG8_SB(0, 0), b2, voffB); PG8_STAGE(PG8_SB(0, 1), b2 + hstepB, voffB); PG8_STAGE(PG8_SA(0, 0), a2, voffA);
            PG8_WAIT_V(8); PG8_WAIT_L(0); PG8_BAR; PG8_MMA(1, 0, At, B0); PG8_MMA(1, 1, At, B1); PG8_BAR; PG8_SCHED;
            PG8_LDB(B0, 1, 0); PG8_LDB(B1, 1, 1); PG8_SCHED; PG8_LDA(At, 1, 0); PG8_STAGE(PG8_SA(0, 1), a2 + hstepA, voffA);
            PG8_WAIT_V(8); PG8_WAIT_L(0); PG8_BAR; PG8_MMA(0, 0, At, B0); PG8_MMA(0, 1, At, B1); PG8_BAR; PG8_SCHED;
            PG8_LDA(At, 1, 1); PG8_STAGE(PG8_SB(1, 0), b3, voffB); PG8_STAGE(PG8_SB(1, 1), b3 + hstepB, voffB); PG8_STAGE(PG8_SA(1, 0), a3, voffA);
            PG8_WAIT_V(8); PG8_WAIT_L(0); PG8_BAR; PG8_MMA(1, 0, At, B0); PG8_MMA(1, 1, At, B1); PG8_BAR; PG8_SCHED;
        }
        if constexpr (ALIGN_EPI) { if (wr == 0) PG8_BAR; }
        E(acc, cur, wr, wc, fr, fq); S.done(cur);
        if (!has_next) break;
#pragma unroll
        for (int a = 0; a < 2; ++a)
#pragma unroll
            for (int b = 0; b < 2; ++b)
#pragma unroll
                for (int m = 0; m < 4; ++m)
#pragma unroll
                    for (int n = 0; n < 2; ++n) acc[a][b][m][n] = (f32x4){0.f, 0.f, 0.f, 0.f};
        cur = nxt; cA = nA; cB = nB; ++ui;
        if constexpr (ALIGN_EPI) { if (wr == 1) PG8_BAR; }
    }
    PG8_WAIT_V(0);
    if constexpr (!ALIGN_EPI) { if (wr == 0) PG8_BAR; }
    PG8_BAR;
#undef PG8_SA
#undef PG8_SB
#undef PG8_STAGE
#undef PG8_LDA
#undef PG8_LDB
#undef PG8_MMA
#undef PG8_WAIT_V
#undef PG8_WAIT_L
#undef PG8_BAR
#undef PG8_SCHED
#undef PG8_AOFF
}
}

#define XB_TMO      128
#define XB_XCNT(j)  (256  + 64 * (j))
#define XB_XSUB(j)  (1280 + 64 * (j))
#define XB_XGEN(j)  (2304 + 64 * (j))
#define XB_TOP      3328
#define XB_TOPGEN   3392
#define XCD_BAR_WORDS 3456
#define XB_SPIN_CAP (1u << 18)

__device__ __forceinline__ unsigned xb_ld(unsigned* p)              { return __hip_atomic_load(p, __ATOMIC_RELAXED, __HIP_MEMORY_SCOPE_AGENT); }
__device__ __forceinline__ unsigned xb_add(unsigned* p, unsigned v) { return __hip_atomic_fetch_add(p, v, __ATOMIC_RELAXED, __HIP_MEMORY_SCOPE_AGENT); }
__device__ __forceinline__ unsigned xb_xcc_id() { return (unsigned)__builtin_amdgcn_s_getreg((3 << 11) | 20) & 0xFu; }
#define XB_SPIN(cond, bar) do { unsigned _sp = 0; while (cond) { __builtin_amdgcn_s_sleep(1); \
    if ((++_sp & 255u) == 0u) { if (xb_ld(&(bar)[XB_TMO])) break; if (_sp > XB_SPIN_CAP) { atomicAdd(&(bar)[XB_TMO], 1u); break; } } } } while (0)

struct XcdBarrier { unsigned* bar; unsigned x; volatile LAS unsigned* st; };

__device__ __forceinline__ XcdBarrier xcd_barrier_post(unsigned* bar, volatile LAS unsigned* st) {
    XcdBarrier b; b.bar = bar; b.x = xb_xcc_id(); b.st = st;
    if (threadIdx.x == 0) (void)xb_add(&bar[XB_XCNT(b.x)], 1u);
    return b;
}
__device__ __forceinline__ void xcd_barrier_complete(unsigned* bar, unsigned x, unsigned& nloc, unsigned& nx) {
    const unsigned G = gridDim.x * gridDim.y * gridDim.z;
    unsigned sum, cnt, mine, sp = 0u;
    for (;;) {
        sum = 0u; cnt = 0u; mine = 0u;
#pragma unroll
        for (unsigned j = 0; j < 16; ++j) { const unsigned c = xb_ld(&bar[XB_XCNT(j)]); sum += c; cnt += (c > 0u) ? 1u : 0u; mine = (j == x) ? c : mine; }
        if (sum == G) break;
        __builtin_amdgcn_s_sleep(1);
        if ((++sp & 255u) == 0u) { if (xb_ld(&bar[XB_TMO])) break; if (sp > XB_SPIN_CAP) { atomicAdd(&bar[XB_TMO], 1u); break; } }
    }
    nloc = mine > 0u ? mine : 1u; nx = cnt > 0u ? cnt : 1u;
}
__device__ __forceinline__ void xcd_barrier(const XcdBarrier& b) {
    asm volatile("s_waitcnt vmcnt(0)" ::: "memory");
    __syncthreads();
    if (threadIdx.x == 0) {
        unsigned* bar = b.bar;
        __builtin_amdgcn_s_waitcnt(0);
        unsigned nloc = b.st[0], nx = b.st[1];
        if (nloc == 0u) { xcd_barrier_complete(bar, b.x, nloc, nx); b.st[0] = nloc; b.st[1] = nx; }
        const unsigned old = xb_add(&bar[XB_XSUB(b.x)], 1u);
        const unsigned gen = old / nloc;
        if (old + 1u == (gen + 1u) * nloc) {
            __builtin_amdgcn_fence(__ATOMIC_RELEASE, "agent");
            asm volatile("s_waitcnt vmcnt(0)" ::: "memory");
            const unsigned og = xb_add(&bar[XB_TOP], 1u);
            const unsigned tg = og / nx;
            if (og + 1u == (tg + 1u) * nx) xb_add(&bar[XB_TOPGEN], 1u);
            else XB_SPIN(xb_ld(&bar[XB_TOPGEN]) == tg, bar);
            __builtin_amdgcn_fence(__ATOMIC_ACQUIRE, "agent");
            xb_add(&bar[XB_XGEN(b.x)], 1u);
            asm volatile("s_waitcnt vmcnt(0)" ::: "memory");
        } else {
            XB_SPIN(xb_ld(&bar[XB_XGEN(b.x)]) == gen, bar);
            __builtin_amdgcn_fence(__ATOMIC_ACQUIRE, "agent");
            asm volatile("s_waitcnt vmcnt(0)" ::: "memory");
        }
    }
    __syncthreads();
}

struct Args { const float* in[15]; float* out; unsigned char* ws; int ph_lo, ph_hi; };
struct Frame {
    LAS unsigned char* lds;
    int tid, lane, wave, vcu, G;
};
__device__ __forceinline__ float wave_sum(float v) {
#pragma unroll
    for (int o = 1; o < 64; o <<= 1) v += __shfl_xor(v, o);
    return v;
}
__device__ __forceinline__ void p0_transpose_item(const float* W, int K, int N, bf16* WT, LAS float* scr, int item, int lane) {
    const int nblk = N / 32, kb = item / nblk, nb = item % nblk, k0 = 64 * kb, n0 = 32 * nb;
#pragma unroll 8
    for (int i = 0; i < 32; ++i) { const int kk = 2 * i + (lane >> 5); scr[kk * 33 + (lane & 31)] = W[(size_t)(k0 + kk) * N + n0 + (lane & 31)]; }
    LDS_WAIT(); asm volatile("" ::: "memory");
    const int c = lane & 7;
#pragma unroll
    for (int j = 0; j < 4; ++j) { const int n = (lane >> 3) + 8 * j; const LAS float* s = scr + (8 * c) * 33 + n;
        v4u o; o.x = pk2(s[0 * 33], s[1 * 33]); o.y = pk2(s[2 * 33], s[3 * 33]); o.z = pk2(s[4 * 33], s[5 * 33]); o.w = pk2(s[6 * 33], s[7 * 33]);
        *(GAS v4u*)(WT + (size_t)(n0 + n) * K + k0 + 8 * c) = o; }
    LDS_WAIT(); asm volatile("" ::: "memory");
}

__device__ __forceinline__ void phase_prologue(Frame& F, const Args& a) {
    unsigned char* ws = a.ws;
    LAS float* scr = (LAS float*)(F.lds + F.wave * 16384);
    const int gw = F.vcu * 8 + F.wave, NGW = F.G * 8;
    constexpr int I_POOL = (1024 / 64) * (1024 / 32);
    constexpr int I_WIN = (DM / 64) * (PW / 32);
    constexpr int I_WOUT = (VD / 64) * (DM / 32);
    constexpr int I_W1 = (DM / 64) * (FF / 32);
    constexpr int I_W2 = (FF / 64) * (DM / 32);
    constexpr int NITEMS = 4 * I_POOL + I_WIN + I_WOUT + 2 * I_W1 + 2 * I_W2;
    for (int it = gw; it < NITEMS; it += NGW) {
        int r = it;
        if (r < 4 * I_POOL) { const int g = r / I_POOL; p0_transpose_item(a.in[4] + (size_t)g * 1024 * 1024, 1024, 1024, (bf16*)(ws + WS_WPOOL) + (size_t)g * 1024 * 1024, scr, r % I_POOL, F.lane); continue; } r -= 4 * I_POOL;
        if (r < I_WIN) { p0_transpose_item(a.in[6], DM, PW, (bf16*)(ws + WS_WIN), scr, r, F.lane); continue; } r -= I_WIN;
        if (r < I_WOUT) { p0_transpose_item(a.in[12], VD, DM, (bf16*)(ws + WS_WOUT), scr, r, F.lane); continue; } r -= I_WOUT;
        if (r < 2 * I_W1) { const int l = r / I_W1; p0_transpose_item(a.in[13] + (size_t)l * DM * FF, DM, FF, (bf16*)(ws + WS_W1) + (size_t)l * DM * FF, scr, r % I_W1, F.lane); continue; } r -= 2 * I_W1;
        { const int l = r / I_W2; p0_transpose_item(a.in[14] + (size_t)l * DM * FF, FF, DM, (bf16*)(ws + WS_W2) + (size_t)l * DM * FF, scr, r % I_W2, F.lane); }
    }
    { GAS v4u* z = (GAS v4u*)((bf16*)(ws + WS_WIN) + (size_t)PW * DM); const int nz = (PWP - PW) * DM / 8;
      for (int i = gw * 64 + F.lane; i < nz; i += NGW * 64) z[i] = (v4u){0u, 0u, 0u, 0u}; }
    const float* x = a.in[0]; float* rstd0 = (float*)(ws + WS_RSTD0);
    for (int m = gw; m < M; m += NGW) {
        const GAS f32x4* xr = (const GAS f32x4*)(x + (size_t)m * DM) + F.lane; float s = 0.f;
#pragma unroll
        for (int j = 0; j < 16; ++j) { const f32x4 v = xr[64 * j]; s += (v.x * v.x + v.y * v.y) + (v.z * v.z + v.w * v.w); }
        s = wave_sum(s);
        if (F.lane == 0) rstd0[m] = 1.0f / sqrtf(s * (1.0f / DM) + EPS);
    }
}

__device__ __forceinline__ void phase_pooldiff(Frame& F, const Args& a) {
    const float* x = a.in[0]; const float* gmix = a.in[1]; const float* rstd0 = (const float*)(a.ws + WS_RSTD0); bf16* D = (bf16*)(a.ws + WS_D);
    for (int it = F.vcu; it < 1024; it += F.G) {
        const int half = it & 1, run = (it >> 1) & 63, b = it >> 7;
        const int c = half * 2048 + F.tid * 4, grp = c >> 10, wh = 1 << grp, t0 = run * 32;
        const f32x4 gv = *(const f32x4*)(gmix + c);
        const float* xb = x + (size_t)b * SEQ * DM + c; const float* rb = rstd0 + b * SEQ;
        f32x4 s = {0.f, 0.f, 0.f, 0.f};
        const int lo0 = (t0 - wh) > 0 ? (t0 - wh) : 0, hi0 = (t0 + wh) < SEQ ? (t0 + wh) : SEQ;
        for (int u = lo0; u < hi0; ++u) s += *(const f32x4*)(xb + (size_t)u * DM) * rb[u];
        for (int t = t0; t < t0 + 32; ++t) {
            const int lo = (t - wh) > 0 ? (t - wh) : 0, hi = (t + wh) < SEQ ? (t + wh) : SEQ;
            const float inv = 1.0f / (float)(hi - lo);
            const f32x4 cen = *(const f32x4*)(xb + (size_t)t * DM) * rb[t];
            const f32x4 d = (s * inv - cen) * gv;
            v2u w; w.x = pk2(d.x, d.y); w.y = pk2(d.z, d.w);
            *(v2u*)(D + ((size_t)(b * SEQ + t)) * DM + c) = w;
            if (t + wh < SEQ) s += *(const f32x4*)(xb + (size_t)(t + wh) * DM) * rb[t + wh];
            if (t - wh >= 0) s -= *(const f32x4*)(xb + (size_t)(t - wh) * DM) * rb[t - wh];
        }
    }
}

__device__ __forceinline__ void phase_gla_decay(Frame& F, const Args& a) {
    const float* R = (const float*)(a.ws + WS_R); float* AD = (float*)(a.ws + WS_AD);
    for (int it = F.vcu; it < 2 * (M / 8); it += F.G) {
        const int dir = it / (M / 8), tb = it % (M / 8);
        const float* wup = a.in[dir ? 9 : 7]; const float* bup = a.in[dir ? 10 : 8];
        for (int j = 0; j < 4; ++j) {
            const int dk = F.tid + 512 * j; float w[16];
#pragma unroll
            for (int r = 0; r < 16; ++r) w[r] = wup[r * KD + dk];
            const float bias = bup[dk];
            for (int t = 0; t < 8; ++t) {
                const int tok = tb * 8 + t; const float* rr = R + (size_t)tok * 32 + dir * 16; float xacc = bias;
#pragma unroll
                for (int r = 0; r < 16; ++r) xacc += rr[r] * w[r];
                const float ls = fminf(xacc, 0.f) - log1pf(__expf(-fabsf(xacc)));
                AD[((size_t)dir * M + tok) * KD + dk] = __expf(ls * (1.0f / 16.0f));
            }
        }
    }
}
__device__ __forceinline__ void phase_gla_recur(Frame& F, const Args& a) {
    const bf16* Qb = (const bf16*)(a.ws + WS_Q); const bf16* Kb = (const bf16*)(a.ws + WS_K); const bf16* Vb = (const bf16*)(a.ws + WS_V);
    const float* AD = (const float*)(a.ws + WS_AD); float* O = (float*)(a.ws + WS_O);
    constexpr int TB = 8, QS = 132;
    LAS float* qs = (LAS float*)F.lds;
    LAS float* ks = qs + TB * 4 * QS;
    LAS float* as = ks + TB * 4 * QS;
    LAS float* vs = as + TB * 4 * QS;
    const int dvl = F.tid >> 2, qt = F.tid & 3;
    const float qscale = 0.044194173824159216f;
    for (int it = F.vcu; it < BATCH * NH * 8; it += F.G) {
        const int blk = it & 7, h = (it >> 3) & 3, b = it >> 5;
        for (int dir = 0; dir < 2; ++dir) {
            float S[128];
#pragma unroll
            for (int i = 0; i < 128; ++i) S[i] = 0.f;
            for (int tb = 0; tb < SEQ / TB; ++tb) {
                __syncthreads();
#pragma unroll
                for (int e = 0; e < 8; ++e) {
                    const int idx = F.tid + 512 * e, tt = idx >> 9, dk = idx & 511;
                    const int sp = tb * TB + tt, tok = b * SEQ + (dir ? (SEQ - 1 - sp) : sp);
                    const int li = tt * 4 * QS + (dk >> 7) * QS + (dk & 127);
                    qs[li] = bf2f(Qb[(size_t)tok * KD + h * HK + dk]) * qscale;
                    ks[li] = bf2f(Kb[(size_t)tok * KD + h * HK + dk]);
                    as[li] = AD[((size_t)dir * M + tok) * KD + h * HK + dk];
                }
#pragma unroll
                for (int e = 0; e < 2; ++e) {
                    const int idx = F.tid + 512 * e, tt = idx >> 7, dv = idx & 127;
                    const int sp = tb * TB + tt, tok = b * SEQ + (dir ? (SEQ - 1 - sp) : sp);
                    vs[tt * 128 + dv] = bf2f(Vb[(size_t)tok * VD + h * HV + blk * 128 + dv]);
                }
                __syncthreads();
                for (int tt = 0; tt < TB; ++tt) {
                    const float v = vs[tt * 128 + dvl]; float o = 0.f;
                    const LAS float* qp = qs + tt * 4 * QS + qt * QS; const LAS float* kp = ks + tt * 4 * QS + qt * QS; const LAS float* ap = as + tt * 4 * QS + qt * QS;
#pragma unroll
                    for (int i = 0; i < 128; i += 4) {
                        const f32x4 q4 = *(const LAS f32x4*)(qp + i), k4 = *(const LAS f32x4*)(kp + i), a4 = *(const LAS f32x4*)(ap + i);
#pragma unroll
                        for (int j = 0; j < 4; ++j) { S[i + j] = a4[j] * S[i + j] + k4[j] * v; o += q4[j] * S[i + j]; }
                    }
                    o += __shfl_xor(o, 1); o += __shfl_xor(o, 2);
                    if (qt == 0) {
                        const int sp = tb * TB + tt, tok = b * SEQ + (dir ? (SEQ - 1 - sp) : sp);
                        float* op = O + (size_t)tok * VD + h * HV + blk * 128 + dvl;
                        if (dir) *op = *op + o; else *op = o;
                    }
                }
            }
        }
    }
}

__device__ __forceinline__ void phase_post(Frame& F, const Args& a) {
    const float* O = (const float*)(a.ws + WS_O); const bf16* Gt = (const bf16*)(a.ws + WS_G); bf16* XA = (bf16*)(a.ws + WS_D); const float* gn = a.in[11];
    const int gw = F.vcu * 8 + F.wave, NGW = F.G * 8;
    f32x4 gv[4];
#pragma unroll
    for (int j = 0; j < 4; ++j) gv[j] = *(const f32x4*)(gn + F.lane * 4 + 256 * j);
    for (int it = gw; it < M * NH; it += NGW) {
        const size_t base = (size_t)(it >> 2) * VD + (it & 3) * HV + F.lane * 4;
        f32x4 o[4]; float s = 0.f;
#pragma unroll
        for (int j = 0; j < 4; ++j) { o[j] = *(const f32x4*)(O + base + 256 * j); s += (o[j].x * o[j].x + o[j].y * o[j].y) + (o[j].z * o[j].z + o[j].w * o[j].w); }
        s = wave_sum(s); const float rs = 1.0f / sqrtf(s * (1.0f / HV) + EPS);
#pragma unroll
        for (int j = 0; j < 4; ++j) {
            const v2u gw2 = *(const v2u*)(Gt + base + 256 * j);
            const float g0 = bf2f((unsigned short)(gw2.x & 0xffffu)), g1 = bf2f((unsigned short)(gw2.x >> 16)), g2 = bf2f((unsigned short)(gw2.y & 0xffffu)), g3 = bf2f((unsigned short)(gw2.y >> 16));
            const f32x4 y = o[j] * rs * gv[j];
            const float r0 = y.x * g0 / (1.0f + __expf(-g0)), r1 = y.y * g1 / (1.0f + __expf(-g1)), r2 = y.z * g2 / (1.0f + __expf(-g2)), r3 = y.w * g3 / (1.0f + __expf(-g3));
            v2u w; w.x = pk2(r0, r1); w.y = pk2(r2, r3);
            *(v2u*)(XA + base + 256 * j) = w;
        }
    }
}
__device__ __forceinline__ void phase_final(Frame& F, const Args& a) {
    float* H = a.out; const float* ss = (const float*)(a.ws + WS_CTL) + CW_SS + 3 * M; const float* gf = a.in[3];
    const int gw = F.vcu * 8 + F.wave, NGW = F.G * 8;
    for (int m = gw; m < M; m += NGW) {
        const float rs = 1.0f / sqrtf(ld_agent(ss + m) * (1.0f / DM) + EPS);
        f32x4* hr = (f32x4*)(H + (size_t)m * DM) + F.lane;
#pragma unroll
        for (int j = 0; j < 16; ++j) { const f32x4 g = *((const f32x4*)gf + F.lane + 64 * j); hr[64 * j] = hr[64 * j] * rs * g; }
    }
}

__global__ void __launch_bounds__(512, 2) mk_fwd(Args args) {
    extern __shared__ __attribute__((aligned(16))) unsigned char lds[];
    Frame F;
    F.lds = (LAS unsigned char*)lds;
    F.tid = threadIdx.x; F.lane = F.tid & 63; F.wave = __builtin_amdgcn_readfirstlane(F.tid >> 6);
    F.G = gridDim.x; { const int bx = blockIdx.x; F.vcu = (F.G % 8 == 0) ? (bx % 8) * (F.G / 8) + bx / 8 : bx; }
    volatile LAS unsigned* MISC = (volatile LAS unsigned*)(F.lds + MISC_OFF);
    if (F.tid < 64) MISC[F.tid] = 0u;
    __syncthreads();
    unsigned char* ws = args.ws;
    unsigned* ctl = (unsigned*)(ws + WS_CTL);
    const int lo = args.ph_lo, hi = args.ph_hi;
    XcdBarrier bar; bar.bar = ctl + CW_BAR; bar.x = 0; bar.st = nullptr;
    if (hi - lo > 1) bar = xcd_barrier_post(ctl + CW_BAR, MISC + 8);
#define IN(k) (lo <= (k) && (k) < hi)
#define SEAM(k) do { if (IN(k) && IN((k) + 1)) xcd_barrier(bar); } while (0)
    float* SS = (float*)ctl + CW_SS;
    float* H = args.out;
    bf16* XN = (bf16*)(ws + WS_XN); bf16* Db = (bf16*)(ws + WS_D); bf16* HID = (bf16*)(ws + WS_HID);
    const float* norm_mix = args.in[1]; const float* norm_mlp = args.in[2];

    if (IN(0)) { phase_prologue(F, args); } SEAM(0);
    if (IN(1)) { phase_pooldiff(F, args); } SEAM(1);
    if (IN(2)) {
        pg8::Gemm g{Db, (const bf16*)(ws + WS_WPOOL), M, DM, 1024, DM, 4}; pg8::StaticOrder S; S.init(M, DM, F.G, (int)blockIdx.x);
        pg8::EpiResid E{args.in[0], H, args.in[5], norm_mlp, XN, SS + 0 * M, DM};
        pg8::gemm_phase<pg8::EpiResid, pg8::StaticOrder>(F.lds, g, S, E);
    } SEAM(2);
    if (IN(3)) {
        pg8::Gemm g{XN, (const bf16*)(ws + WS_W1), M, FF, DM, DM, 0}; pg8::StaticOrder S; S.init(M, FF, F.G, (int)blockIdx.x);
        pg8::EpiRelu2 E{HID, FF, SS + 0 * M};
        pg8::gemm_phase<pg8::EpiRelu2, pg8::StaticOrder>(F.lds, g, S, E);
    } SEAM(3);
    if (IN(4)) {
        pg8::Gemm g{HID, (const bf16*)(ws + WS_W2), M, DM, FF, FF, 0}; pg8::StaticOrder S; S.init(M, DM, F.G, (int)blockIdx.x);
        pg8::EpiResid E{H, H, nullptr, norm_mix + DM, XN, SS + 1 * M, DM};
        pg8::gemm_phase<pg8::EpiResid, pg8::StaticOrder>(F.lds, g, S, E);
    } SEAM(4);
    if (IN(5)) {
        pg8::Gemm g{XN, (const bf16*)(ws + WS_WIN), M, PWP, DM, DM, 0}; pg8::StaticOrder S; S.init(M, PWP, F.G, (int)blockIdx.x);
        pg8::EpiInProj E{(bf16*)(ws + WS_Q), (bf16*)(ws + WS_K), (bf16*)(ws + WS_V), (bf16*)(ws + WS_G), (float*)(ws + WS_R), SS + 1 * M};
        pg8::gemm_phase<pg8::EpiInProj, pg8::StaticOrder>(F.lds, g, S, E);
    } SEAM(5);
    if (IN(6)) { phase_gla_decay(F, args); } SEAM(6);
    if (IN(7)) { phase_gla_recur(F, args); } SEAM(7);
    if (IN(8)) { phase_post(F, args); } SEAM(8);
    if (IN(9)) {
        pg8::Gemm g{Db, (const bf16*)(ws + WS_WOUT), M, DM, VD, VD, 0}; pg8::StaticOrder S; S.init(M, DM, F.G, (int)blockIdx.x);
        pg8::EpiResid E{H, H, nullptr, norm_mlp + DM, XN, SS + 2 * M, DM};
        pg8::gemm_phase<pg8::EpiResid, pg8::StaticOrder>(F.lds, g, S, E);
    } SEAM(9);
    if (IN(10)) {
        pg8::Gemm g{XN, (const bf16*)(ws + WS_W1) + (size_t)DM * FF, M, FF, DM, DM, 0}; pg8::StaticOrder S; S.init(M, FF, F.G, (int)blockIdx.x);
        pg8::EpiRelu2 E{HID, FF, SS + 2 * M};
        pg8::gemm_phase<pg8::EpiRelu2, pg8::StaticOrder>(F.lds, g, S, E);
    } SEAM(10);
    if (IN(11)) {
        pg8::Gemm g{HID, (const bf16*)(ws + WS_W2) + (size_t)DM * FF, M, DM, FF, FF, 0}; pg8::StaticOrder S; S.init(M, DM, F.G, (int)blockIdx.x);
        pg8::EpiResid E{H, H, nullptr, nullptr, nullptr, SS + 3 * M, DM};
        pg8::gemm_phase<pg8::EpiResid, pg8::StaticOrder>(F.lds, g, S, E);
    } SEAM(11);
    if (IN(12)) { phase_final(F, args); }
#undef IN
#undef SEAM
}

extern "C" void kernel_launch(void* const* d_in, const int* in_sizes, int n_in, void* d_out, int out_size, void* d_ws, size_t ws_size, hipStream_t stream) {
    static int grid = 0;
    if (grid == 0) {
        if (n_in != 15 || in_sizes[0] != M * DM || out_size != M * DM || ws_size < WS_END) {
            fprintf(stderr, "kernel_launch: unexpected problem (n_in %d, in0 %d, out %d, ws %zu < %zu); nothing launched\n", n_in, n_in > 0 ? in_sizes[0] : -1, out_size, ws_size, (size_t)WS_END); grid = -1; return; }
        int dev = 0, cus = 0;
        if (hipGetDevice(&dev) != hipSuccess || hipDeviceGetAttribute(&cus, hipDeviceAttributeMultiprocessorCount, dev) != hipSuccess) { grid = -1; return; }
        if (hipFuncSetAttribute((const void*)mk_fwd, hipFuncAttributeMaxDynamicSharedMemorySize, LDS_BYTES) != hipSuccess) { fprintf(stderr, "kernel_launch: hipFuncSetAttribute failed\n"); grid = -1; return; }
        int per_cu = 0;
        if (hipOccupancyMaxActiveBlocksPerMultiprocessor(&per_cu, (const void*)mk_fwd, 512, LDS_BYTES) != hipSuccess || per_cu < 1) fprintf(stderr, "kernel_launch: occupancy query says %d\n", per_cu);
        (void)hipGetLastError();
        grid = cus;
    }
    if (grid < 0) return;
    (void)hipMemsetAsync((char*)d_ws + WS_CTL, 0, CTL_ZERO_BYTES, stream);
    Args a{};
    for (int i = 0; i < 15; ++i) a.in[i] = (const float*)d_in[i];
    a.out = (float*)d_out; a.ws = (unsigned char*)d_ws;
#if MK_PER_PHASE
    for (int p = 0; p < NPHASE; ++p) { a.ph_lo = p; a.ph_hi = p + 1; hipLaunchKernelGGL(mk_fwd, dim3(grid), dim3(512), LDS_BYTES, stream, a); }
#else
    a.ph_lo = 0; a.ph_hi = NPHASE; hipLaunchKernelGGL(mk_fwd, dim3(grid), dim3(512), LDS_BYTES, stream, a);
#endif
}
```

```cpp
#include <hip/hip_runtime.h>
#include <cstdio>
#include <cstdint>

#ifndef MK_PER_PHASE
#define MK_PER_PHASE 0
#endif

constexpr int BATCH = 8, SEQ = 2048, DM = 4096, M = BATCH * SEQ, FF = 4 * DM;
constexpr int NH = 4, KD = DM / 2, VD = DM, HK = KD / NH, HV = VD / NH, GR = 16;
constexpr int PW = 2 * KD + 2 * VD + 2 * GR;
constexpr int PWP = 12544;
constexpr float EPS = 1e-6f;
constexpr int NPHASE = 13;

constexpr size_t MiB = 1u << 20;
constexpr size_t WS_CTL = 0, CTL_ZERO_BYTES = 1 * MiB;
constexpr size_t WS_WPOOL = 2 * MiB;
constexpr size_t WS_WOUT = 10 * MiB;
constexpr size_t WS_WIN = 42 * MiB;
constexpr size_t WS_W1_0 = 140 * MiB, WS_W1_1 = 396 * MiB;
constexpr size_t WS_W2_0 = 268 * MiB, WS_W2_1 = 524 * MiB;
constexpr size_t WS_OB = 140 * MiB;
constexpr size_t WS_XN = 652 * MiB;
constexpr size_t WS_D = 780 * MiB;
constexpr size_t WS_HID = 908 * MiB;
constexpr size_t WS_Q = 908 * MiB;
constexpr size_t WS_K = 972 * MiB;
constexpr size_t WS_V = 1036 * MiB;
constexpr size_t WS_G = 1164 * MiB;
constexpr size_t WS_R = 1292 * MiB;
constexpr size_t WS_QT = 1294 * MiB;
constexpr size_t WS_KT = 1422 * MiB;
constexpr size_t WS_PA = 1550 * MiB;
constexpr size_t WS_OF = 1570 * MiB;
constexpr size_t WS_RSTD0 = 1826 * MiB;
constexpr size_t WS_END = 1827 * MiB;
constexpr int CW_BAR = 4096;
constexpr int CW_SS = 131072;

constexpr int LDS_BYTES = 159 * 1024;
constexpr int RING_BYTES = 131072;
constexpr int MISC_OFF = LDS_BYTES - 256;

#define GAS __attribute__((address_space(1)))
#define LAS __attribute__((address_space(3)))
typedef unsigned short bf16;
typedef unsigned v4u __attribute__((ext_vector_type(4)));
typedef unsigned v2u __attribute__((ext_vector_type(2)));
typedef float f32x4 __attribute__((ext_vector_type(4)));
typedef short bf16x8 __attribute__((ext_vector_type(8)));
#define LDS_WAIT() asm volatile("s_waitcnt lgkmcnt(0)" ::: "memory")
#define VM_WAIT() asm volatile("s_waitcnt vmcnt(0)" ::: "memory")
__device__ __forceinline__ unsigned f2bf(float f) { unsigned u = __builtin_bit_cast(unsigned, f); return (u + 0x7fffu + ((u >> 16) & 1u)) >> 16; }
__device__ __forceinline__ unsigned pk2(float lo, float hi) { return f2bf(lo) | (f2bf(hi) << 16); }
__device__ __forceinline__ float bf2f(unsigned short b) { return __builtin_bit_cast(float, ((unsigned)b) << 16); }
__device__ __forceinline__ float ld_agent(const float* p) { return __builtin_bit_cast(float, __hip_atomic_load((const unsigned*)p, __ATOMIC_RELAXED, __HIP_MEMORY_SCOPE_AGENT)); }

namespace pg8 {
#define PG8_LAS __attribute__((address_space(3)))
typedef unsigned short bf16_t;
typedef unsigned u32x4 __attribute__((ext_vector_type(4)));
constexpr int BM = 256, BK = 64, HALF = 128, HTB = HALF * BK * 2, STAGE_BYTES = 8 * HTB, NXCD = 8, WGM = 8;

__host__ __device__ __forceinline__ int lds_byte(int r, int c) { const int st = (r >> 4) * 2 + (c >> 5), rr = r & 15, cc = c & 31, ob = rr * 64 + cc * 2; return st * 1024 + (ob ^ (((ob >> 9) & 1) << 5)); }
__host__ __device__ __forceinline__ void stage_rc(int b, int& R, int& C) { const int st = b / 1024, sb = b % 1024, swz = sb ^ (((sb >> 9) & 1) << 5); R = (st >> 1) * 16 + swz / 64; C = (st & 1) * 32 + (swz % 64) / 2; }
__host__ __device__ __forceinline__ int perm32(int rho) { const int n = rho >> 4, i = rho & 15; return 8 * (i >> 2) + 4 * n + (i & 3); }

struct Unit { int pm, pn; };
struct Gemm { const bf16_t* A; const bf16_t* Bt; int M, N, K, lda, grp; };

struct StaticOrder {
    int nM, nN, nwg, G, c;
    __host__ __device__ void init(int M_, int N_, int G_, int c_) { nM = M_ / BM; nN = N_ / BM; nwg = nM * nN; G = G_; c = c_; }
    __host__ __device__ bool next(int i, Unit& u) const {
        const long L = (long)i * G + c; if (L >= nwg) return false;
        int wgid = (int)L; { const int q = nwg / NXCD, r = nwg % NXCD, xcd = wgid % NXCD, off = wgid / NXCD; wgid = (xcd < r ? xcd * (q + 1) : r * (q + 1) + (xcd - r) * q) + off; }
        const int nig = WGM * nN, gid = wgid / nig, fm = gid * WGM, gsz = (nM - fm) < WGM ? (nM - fm) : WGM;
        u.pm = fm + ((wgid % nig) % gsz); u.pn = (wgid % nig) / gsz; return true;
    }
    __device__ __forceinline__ void a_ready(const Unit&) const {}
    __device__ __forceinline__ void done(const Unit&) const {}
};

__device__ __forceinline__ unsigned cvt_pk_bf16(float lo, float hi) { unsigned r; asm volatile("v_cvt_pk_bf16_f32 %0, %1, %2" : "=v"(r) : "v"(lo), "v"(hi)); return r; }


struct EpiResid {
    static constexpr bool PERM = true, AFTER_DRAIN = false;
    const float* hin; float* hout; const float* cscale; const float* gnext; bf16_t* xn; float* ss; int ldc;
    __device__ __forceinline__ void operator()(const f32x4 (&acc)[2][2][4][2], const Unit& u, int wr, int wc, int fr, int fq) const {
        const int row0 = u.pm * BM + wr * 64 + fr, col0 = u.pn * BM + wc * 32 + 8 * fq;
        f32x4 sc[2][2], gn[2][2];
#pragma unroll
        for (int bj = 0; bj < 2; ++bj)
#pragma unroll
            for (int n = 0; n < 2; ++n) {
                sc[bj][n] = cscale ? *(const f32x4*)(cscale + col0 + bj * HALF + 4 * n) : (f32x4){1.f, 1.f, 1.f, 1.f};
                gn[bj][n] = gnext ? *(const f32x4*)(gnext + col0 + bj * HALF + 4 * n) : (f32x4){1.f, 1.f, 1.f, 1.f};
            }
#pragma unroll
        for (int ai = 0; ai < 2; ++ai)
#pragma unroll
            for (int m = 0; m < 4; ++m) {
                const int r = row0 + ai * HALF + m * 16; const size_t off = (size_t)r * ldc + col0; float s = 0.f;
#pragma unroll
                for (int bj = 0; bj < 2; ++bj) {
                    const f32x4 h0 = *(const f32x4*)(hin + off + bj * HALF), h1 = *(const f32x4*)(hin + off + bj * HALF + 4);
                    const f32x4 v0 = h0 + acc[ai][bj][m][0] * sc[bj][0], v1 = h1 + acc[ai][bj][m][1] * sc[bj][1];
                    *(f32x4*)(hout + off + bj * HALF) = v0; *(f32x4*)(hout + off + bj * HALF + 4) = v1;
                    s += (v0[0] * v0[0] + v0[1] * v0[1]) + (v0[2] * v0[2] + v0[3] * v0[3]) + (v1[0] * v1[0] + v1[1] * v1[1]) + (v1[2] * v1[2] + v1[3] * v1[3]);
                    if (xn) { const f32x4 a = v0 * gn[bj][0], b = v1 * gn[bj][1]; u32x4 w; w.x = cvt_pk_bf16(a[0], a[1]); w.y = cvt_pk_bf16(a[2], a[3]); w.z = cvt_pk_bf16(b[0], b[1]); w.w = cvt_pk_bf16(b[2], b[3]);
                        *(u32x4*)(xn + off + bj * HALF) = w; }
                }
                s += __shfl_xor(s, 16); s += __shfl_xor(s, 32);
                if (fq == 0) unsafeAtomicAdd(ss + r, s);
                asm volatile("" ::: "memory");
            }
    }
};
struct EpiRelu2 {
    static constexpr bool PERM = true, AFTER_DRAIN = false;
    bf16_t* O; int ldc; const float* ss;
    __device__ __forceinline__ void operator()(const f32x4 (&acc)[2][2][4][2], const Unit& u, int wr, int wc, int fr, int fq) const {
        const int row0 = u.pm * BM + wr * 64 + fr, col0 = u.pn * BM + wc * 32 + 8 * fq;
#pragma unroll
        for (int ai = 0; ai < 2; ++ai)
#pragma unroll
            for (int m = 0; m < 4; ++m) {
                const int r = row0 + ai * HALF + m * 16; const float rs = 1.0f / sqrtf(ld_agent(ss + r) * (1.0f / DM) + EPS);
                bf16_t* rowp = O + (size_t)r * ldc + col0;
#pragma unroll
                for (int bj = 0; bj < 2; ++bj) { f32x4 v0 = acc[ai][bj][m][0] * rs, v1 = acc[ai][bj][m][1] * rs;
#pragma unroll
                    for (int j = 0; j < 4; ++j) { const float a = fmaxf(v0[j], 0.f), b = fmaxf(v1[j], 0.f); v0[j] = a * a; v1[j] = b * b; }
                    u32x4 w; w.x = cvt_pk_bf16(v0[0], v0[1]); w.y = cvt_pk_bf16(v0[2], v0[3]); w.z = cvt_pk_bf16(v1[0], v1[1]); w.w = cvt_pk_bf16(v1[2], v1[3]);
                    *(u32x4*)(rowp + bj * HALF) = w; }
            }
    }
};
struct EpiInProj {
    static constexpr bool PERM = true, AFTER_DRAIN = false;
    bf16_t *Q, *K, *V, *G; float* R; const float* ss;
    __device__ __forceinline__ void operator()(const f32x4 (&acc)[2][2][4][2], const Unit& u, int wr, int wc, int fr, int fq) const {
        const int row0 = u.pm * BM + wr * 64 + fr; const int pn = u.pn;
        bf16_t* base; int ldc, colt;
        if (pn < 8) { base = Q; ldc = KD; colt = pn * BM; } else if (pn < 16) { base = K; ldc = KD; colt = (pn - 8) * BM; }
        else if (pn < 32) { base = V; ldc = VD; colt = (pn - 16) * BM; } else { base = G; ldc = VD; colt = (pn - 32) * BM; }
        const int col0 = colt + wc * 32 + 8 * fq;
#pragma unroll
        for (int ai = 0; ai < 2; ++ai)
#pragma unroll
            for (int m = 0; m < 4; ++m) {
                const int r = row0 + ai * HALF + m * 16; const float rs = 1.0f / sqrtf(ld_agent(ss + r) * (1.0f / DM) + EPS);
                if (pn < 48) {
                    bf16_t* rowp = base + (size_t)r * ldc + col0;
#pragma unroll
                    for (int bj = 0; bj < 2; ++bj) { const f32x4 v0 = acc[ai][bj][m][0] * rs, v1 = acc[ai][bj][m][1] * rs;
                        u32x4 w; w.x = cvt_pk_bf16(v0[0], v0[1]); w.y = cvt_pk_bf16(v0[2], v0[3]); w.z = cvt_pk_bf16(v1[0], v1[1]); w.w = cvt_pk_bf16(v1[2], v1[3]);
                        *(u32x4*)(rowp + bj * HALF) = w; }
                } else if (wc == 0) {
                    float* rp = R + (size_t)r * 32 + 8 * fq;
                    *(f32x4*)rp = acc[ai][0][m][0] * rs; *(f32x4*)(rp + 4) = acc[ai][0][m][1] * rs;
                }
            }
    }
};

template <class Epi, class Sched, bool ALIGN_EPI = true>
__device__ __forceinline__ void gemm_phase(PG8_LAS unsigned char* lds, const Gemm g, const Sched& S, const Epi& E) {
    const int tid = threadIdx.x, wid = __builtin_amdgcn_readfirstlane(tid >> 6), lane = tid & 63, wr = wid >> 2, wc = wid & 3, fr = lane & 15, fq = lane >> 4;
    const int K = g.K, nt = K / BK, lda = g.lda;
    unsigned voffA[2], voffB[2];
#pragma unroll
    for (int i = 0; i < 2; ++i) { int R, C; stage_rc(tid * 16 + i * 8192, R, C); const int Rb = Epi::PERM ? ((R & ~31) + perm32(R & 31)) : R;
        voffA[i] = (unsigned)(R * lda + C) * 2u; voffB[i] = (unsigned)(Rb * K + C) * 2u; }
    const size_t kstep = (size_t)(BK * 2);
    const size_t hstepA = (size_t)HALF * lda * 2, hstepB = (size_t)HALF * K * 2;
    const size_t tstepA = 2 * hstepA, tstepB = 2 * hstepB;
    const unsigned ldsw = (unsigned)wid * 1024u;
    const int aoff = lds_byte(wr * 64 + fr, fq * 8), boff = lds_byte(wc * 32 + fr, fq * 8);
#define PG8_SA(b, h) (((b) * 2 + (h)) * HTB)
#define PG8_SB(b, h) ((4 + (b) * 2 + (h)) * HTB)
#define PG8_STAGE(bufoff, gbase, voff) do { _Pragma("unroll") for (int _i = 0; _i < 2; ++_i) \
        __builtin_amdgcn_global_load_lds((const unsigned*)((const char*)(gbase) + (voff)[_i]), (PG8_LAS unsigned*)(lds + (bufoff) + ldsw + _i * 8192), 16, 0, 0); } while (0)
#define PG8_LDA(dst, b, h) do { _Pragma("unroll") for (int m = 0; m < 4; ++m) _Pragma("unroll") for (int k = 0; k < 2; ++k) dst[m][k] = *(const PG8_LAS bf16x8*)(lds + PG8_SA(b, h) + aoff + m * 2048 + k * 1024); } while (0)
#define PG8_LDB(dst, b, h) do { _Pragma("unroll") for (int n = 0; n < 2; ++n) _Pragma("unroll") for (int k = 0; k < 2; ++k) dst[n][k] = *(const PG8_LAS bf16x8*)(lds + PG8_SB(b, h) + boff + n * 2048 + k * 1024); } while (0)
#define PG8_MMA(ai, bj, At, Bt) do { __builtin_amdgcn_s_setprio(1); _Pragma("unroll") for (int m = 0; m < 4; ++m) _Pragma("unroll") for (int n = 0; n < 2; ++n) _Pragma("unroll") for (int k = 0; k < 2; ++k) \
        acc[ai][bj][m][n] = __builtin_amdgcn_mfma_f32_16x16x32_bf16(Bt[n][k], At[m][k], acc[ai][bj][m][n], 0, 0, 0); __builtin_amdgcn_s_setprio(0); } while (0)
#define PG8_WAIT_V(n) asm volatile("s_waitcnt vmcnt(" #n ")" ::: "memory")
#define PG8_WAIT_L(n) asm volatile("s_waitcnt lgkmcnt(" #n ")" ::: "memory")
#define PG8_BAR __builtin_amdgcn_s_barrier()
#define PG8_SCHED __builtin_amdgcn_sched_barrier(0)
#define PG8_AOFF(u) ((size_t)(u).pm * tstepA + (g.grp ? (size_t)((u).pn / g.grp) * (size_t)K * 2 : (size_t)0))
    Unit cur, nxt; int ui = 0;
    if (!S.next(0, cur)) return;
    f32x4 acc[2][2][4][2];
#pragma unroll
    for (int a = 0; a < 2; ++a)
#pragma unroll
        for (int b = 0; b < 2; ++b)
#pragma unroll
            for (int m = 0; m < 4; ++m)
#pragma unroll
                for (int n = 0; n < 2; ++n) acc[a][b][m][n] = (f32x4){0.f, 0.f, 0.f, 0.f};
    bf16x8 At[4][2], B0[2][2], B1[2][2];
    const char* cA = (const char*)g.A + PG8_AOFF(cur); const char* cB = (const char*)g.Bt + (size_t)cur.pn * tstepB;
    S.a_ready(cur);
    PG8_STAGE(PG8_SB(0, 0), cB, voffB); PG8_STAGE(PG8_SB(0, 1), cB + hstepB, voffB); PG8_STAGE(PG8_SA(0, 0), cA, voffA); PG8_STAGE(PG8_SA(0, 1), cA + hstepA, voffA);
    if (wr == 1) PG8_BAR;
    PG8_WAIT_V(2); PG8_BAR;
    PG8_STAGE(PG8_SB(1, 0), cB + kstep, voffB); PG8_STAGE(PG8_SA(1, 0), cA + kstep, voffA); PG8_STAGE(PG8_SB(1, 1), cB + hstepB + kstep, voffB);
    PG8_WAIT_V(6); PG8_BAR;
    for (;;) {
        const bool has_next = S.next(ui + 1, nxt);
        const char* nA = has_next ? (const char*)g.A + PG8_AOFF(nxt) : cA; const char* nB = has_next ? (const char*)g.Bt + (size_t)nxt.pn * tstepB : cB;
        for (int t = 0; t < nt; t += 2) {
            const bool last = (t == nt - 2);
            const char* a1 = cA + (size_t)(t + 1) * kstep;
            const char* a2 = last ? nA : cA + (size_t)(t + 2) * kstep; const char* b2 = last ? nB : cB + (size_t)(t + 2) * kstep;
            const char* a3 = a2 + kstep; const char* b3 = b2 + kstep;
            if (last && has_next) S.a_ready(nxt);
            PG8_LDB(B0, 0, 0); PG8_LDB(B1, 0, 1); PG8_SCHED; PG8_LDA(At, 0, 0); PG8_STAGE(PG8_SA(1, 1), a1 + hstepA, voffA);
            PG8_WAIT_V(8); PG8_WAIT_L(0); PG8_BAR; PG8_MMA(0, 0, At, B0); PG8_MMA(0, 1, At, B1); PG8_BAR; PG8_SCHED;
            PG8_LDA(At, 0, 1); PG8_STAGE(PG8_SB(0, 0), b2, voffB); PG8_STAGE(PG8_SB(0, 1), b2 + hstepB, voffB); PG8_STAGE(PG8_SA(0, 0), a2, voffA);
            PG8_WAIT_V(8); PG8_WAIT_L(0); PG8_BAR; PG8_MMA(1, 0, At, B0); PG8_MMA(1, 1, At, B1); PG8_BAR; PG8_SCHED;
            PG8_LDB(B0, 1, 0); PG8_LDB(B1, 1, 1); PG8_SCHED; PG8_LDA(At, 1, 0); PG8_STAGE(PG8_SA(0, 1), a2 + hstepA, voffA);
            PG8_WAIT_V(8); PG8_WAIT_L(0); PG8_BAR; PG8_MMA(0, 0, At, B0); PG8_MMA(0, 1, At, B1); PG8_BAR; PG8_SCHED;
            PG8_LDA(At, 1, 1); PG8_STAGE(PG8_SB(1, 0), b3, voffB); PG8_STAGE(PG8_SB(1, 1), b3 + hstepB, voffB); PG8_STAGE(PG8_SA(1, 0), a3, voffA);
            PG8_WAIT_V(8); PG8_WAIT_L(0); PG8_BAR; PG8_MMA(1, 0, At, B0); PG8_MMA(1, 1, At, B1); PG8_BAR; PG8_SCHED;
        }
        if constexpr (ALIGN_EPI) { if (wr == 0) PG8_BAR; }
        E(acc, cur, wr, wc, fr, fq); S.done(cur);
        if (!has_next) break;
#pragma unroll
        for (int a = 0; a < 2; ++a)
#pragma unroll
            for (int b = 0; b < 2; ++b)
#pragma unroll
                for (int m = 0; m < 4; ++m)
#pragma unroll
                    for (int n = 0; n < 2; ++n) acc[a][b][m][n] = (f32x4){0.f, 0.f, 0.f, 0.f};
        cur = nxt; cA = nA; cB = nB; ++ui;
        if constexpr (ALIGN_EPI) { if (wr == 1) PG8_BAR; }
    }
    PG8_WAIT_V(0);
    if constexpr (!ALIGN_EPI) { if (wr == 0) PG8_BAR; }
    PG8_BAR;
#undef PG8_SA
#undef PG8_SB
#undef PG8_STAGE
#undef PG8_LDA
#undef PG8_LDB
#undef PG8_MMA
#undef PG8_WAIT_V
#undef PG8_WAIT_L
#undef PG8_BAR
#undef PG8_SCHED
#undef PG8_AOFF
}
}

#define XB_TMO      128
#define XB_XCNT(j)  (256  + 64 * (j))
#define XB_XSUB(j)  (1280 + 64 * (j))
#define XB_XGEN(j)  (2304 + 64 * (j))
#define XB_TOP      3328
#define XB_TOPGEN   3392
#define XCD_BAR_WORDS 3456
#define XB_SPIN_CAP (1u << 18)

__device__ __forceinline__ unsigned xb_ld(unsigned* p)              { return __hip_atomic_load(p, __ATOMIC_RELAXED, __HIP_MEMORY_SCOPE_AGENT); }
__device__ __forceinline__ unsigned xb_add(unsigned* p, unsigned v) { return __hip_atomic_fetch_add(p, v, __ATOMIC_RELAXED, __HIP_MEMORY_SCOPE_AGENT); }
__device__ __forceinline__ unsigned xb_xcc_id() { return (unsigned)__builtin_amdgcn_s_getreg((3 << 11) | 20) & 0xFu; }
#define XB_SPIN(cond, bar) do { unsigned _sp = 0; while (cond) { __builtin_amdgcn_s_sleep(1); \
    if ((++_sp & 255u) == 0u) { if (xb_ld(&(bar)[XB_TMO])) break; if (_sp > XB_SPIN_CAP) { atomicAdd(&(bar)[XB_TMO], 1u); break; } } } } while (0)

struct XcdBarrier { unsigned* bar; unsigned x; volatile LAS unsigned* st; };

__device__ __forceinline__ XcdBarrier xcd_barrier_post(unsigned* bar, volatile LAS unsigned* st) {
    XcdBarrier b; b.bar = bar; b.x = xb_xcc_id(); b.st = st;
    if (threadIdx.x == 0) (void)xb_add(&bar[XB_XCNT(b.x)], 1u);
    return b;
}
__device__ __forceinline__ void xcd_barrier_complete(unsigned* bar, unsigned x, unsigned& nloc, unsigned& nx) {
    const unsigned G = gridDim.x * gridDim.y * gridDim.z;
    unsigned sum, cnt, mine, sp = 0u;
    for (;;) {
        sum = 0u; cnt = 0u; mine = 0u;
#pragma unroll
        for (unsigned j = 0; j < 16; ++j) { const unsigned c = xb_ld(&bar[XB_XCNT(j)]); sum += c; cnt += (c > 0u) ? 1u : 0u; mine = (j == x) ? c : mine; }
        if (sum == G) break;
        __builtin_amdgcn_s_sleep(1);
        if ((++sp & 255u) == 0u) { if (xb_ld(&bar[XB_TMO])) break; if (sp > XB_SPIN_CAP) { atomicAdd(&bar[XB_TMO], 1u); break; } }
    }
    nloc = mine > 0u ? mine : 1u; nx = cnt > 0u ? cnt : 1u;
}
__device__ __forceinline__ void xcd_barrier(const XcdBarrier& b) {
    asm volatile("s_waitcnt vmcnt(0)" ::: "memory");
    __syncthreads();
    if (threadIdx.x == 0) {
        unsigned* bar = b.bar;
        __builtin_amdgcn_s_waitcnt(0);
        unsigned nloc = b.st[0], nx = b.st[1];
        if (nloc == 0u) { xcd_barrier_complete(bar, b.x, nloc, nx); b.st[0] = nloc; b.st[1] = nx; }
        const unsigned old = xb_add(&bar[XB_XSUB(b.x)], 1u);
        const unsigned gen = old / nloc;
        if (old + 1u == (gen + 1u) * nloc) {
            __builtin_amdgcn_fence(__ATOMIC_RELEASE, "agent");
            asm volatile("s_waitcnt vmcnt(0)" ::: "memory");
            const unsigned og = xb_add(&bar[XB_TOP], 1u);
            const unsigned tg = og / nx;
            if (og + 1u == (tg + 1u) * nx) xb_add(&bar[XB_TOPGEN], 1u);
            else XB_SPIN(xb_ld(&bar[XB_TOPGEN]) == tg, bar);
            __builtin_amdgcn_fence(__ATOMIC_ACQUIRE, "agent");
            xb_add(&bar[XB_XGEN(b.x)], 1u);
            asm volatile("s_waitcnt vmcnt(0)" ::: "memory");
        } else {
            XB_SPIN(xb_ld(&bar[XB_XGEN(b.x)]) == gen, bar);
            __builtin_amdgcn_fence(__ATOMIC_ACQUIRE, "agent");
            asm volatile("s_waitcnt vmcnt(0)" ::: "memory");
        }
    }
    __syncthreads();
}

struct Args { const float* in[15]; float* out; unsigned char* ws; int ph_lo, ph_hi; };
struct Frame {
    LAS unsigned char* lds;
    int tid, lane, wave, vcu, G;
};
__device__ __forceinline__ float wave_sum(float v) {
#pragma unroll
    for (int o = 1; o < 64; o <<= 1) v += __shfl_xor(v, o);
    return v;
}
__device__ __forceinline__ void p0_transpose_item(const float* W, int K, int N, bf16* WT, LAS float* scr, int item, int lane) {
    const int nblk = N / 32, kb = item / nblk, nb = item % nblk, k0 = 64 * kb, n0 = 32 * nb;
#pragma unroll 8
    for (int i = 0; i < 32; ++i) { const int kk = 2 * i + (lane >> 5); scr[kk * 33 + (lane & 31)] = W[(size_t)(k0 + kk) * N + n0 + (lane & 31)]; }
    LDS_WAIT(); asm volatile("" ::: "memory");
    const int c = lane & 7;
#pragma unroll
    for (int j = 0; j < 4; ++j) { const int n = (lane >> 3) + 8 * j; const LAS float* s = scr + (8 * c) * 33 + n;
        v4u o; o.x = pk2(s[0 * 33], s[1 * 33]); o.y = pk2(s[2 * 33], s[3 * 33]); o.z = pk2(s[4 * 33], s[5 * 33]); o.w = pk2(s[6 * 33], s[7 * 33]);
        *(GAS v4u*)(WT + (size_t)(n0 + n) * K + k0 + 8 * c) = o; }
    LDS_WAIT(); asm volatile("" ::: "memory");
}

__device__ __forceinline__ void phase_prologue(Frame& F, const Args& a) {
    unsigned char* ws = a.ws;
    LAS float* scr = (LAS float*)(F.lds + F.wave * 16384);
    const int gw = F.vcu * 8 + F.wave, NGW = F.G * 8;
    constexpr int I_POOL = (1024 / 64) * (1024 / 32);
    constexpr int I_WIN = (DM / 64) * (PW / 32);
    constexpr int I_WOUT = (VD / 64) * (DM / 32);
    constexpr int I_W1 = (DM / 64) * (FF / 32);
    constexpr int I_W2 = (FF / 64) * (DM / 32);
    constexpr int NITEMS = 4 * I_POOL + I_WIN + I_WOUT + 2 * I_W1 + 2 * I_W2;
    for (int it = gw; it < NITEMS; it += NGW) {
        int r = it;
        if (r < 4 * I_POOL) { const int g = r / I_POOL; p0_transpose_item(a.in[4] + (size_t)g * 1024 * 1024, 1024, 1024, (bf16*)(ws + WS_WPOOL) + (size_t)g * 1024 * 1024, scr, r % I_POOL, F.lane); continue; } r -= 4 * I_POOL;
        if (r < I_WIN) { p0_transpose_item(a.in[6], DM, PW, (bf16*)(ws + WS_WIN), scr, r, F.lane); continue; } r -= I_WIN;
        if (r < I_WOUT) { p0_transpose_item(a.in[12], VD, DM, (bf16*)(ws + WS_WOUT), scr, r, F.lane); continue; } r -= I_WOUT;
        if (r < 2 * I_W1) { const int l = r / I_W1; p0_transpose_item(a.in[13] + (size_t)l * DM * FF, DM, FF, (bf16*)(ws + (l ? WS_W1_1 : WS_W1_0)), scr, r % I_W1, F.lane); continue; } r -= 2 * I_W1;
        { const int l = r / I_W2; p0_transpose_item(a.in[14] + (size_t)l * DM * FF, FF, DM, (bf16*)(ws + (l ? WS_W2_1 : WS_W2_0)), scr, r % I_W2, F.lane); }
    }
    { GAS v4u* z = (GAS v4u*)((bf16*)(ws + WS_WIN) + (size_t)PW * DM); const int nz = (PWP - PW) * DM / 8;
      for (int i = gw * 64 + F.lane; i < nz; i += NGW * 64) z[i] = (v4u){0u, 0u, 0u, 0u}; }
    const float* x = a.in[0]; float* rstd0 = (float*)(ws + WS_RSTD0);
    for (int m = gw; m < M; m += NGW) {
        const GAS f32x4* xr = (const GAS f32x4*)(x + (size_t)m * DM) + F.lane; float s = 0.f;
#pragma unroll
        for (int j = 0; j < 16; ++j) { const f32x4 v = xr[64 * j]; s += (v.x * v.x + v.y * v.y) + (v.z * v.z + v.w * v.w); }
        s = wave_sum(s);
        if (F.lane == 0) rstd0[m] = 1.0f / sqrtf(s * (1.0f / DM) + EPS);
    }
}

__device__ __forceinline__ void phase_pooldiff(Frame& F, const Args& a) {
    const float* x = a.in[0]; const float* gmix = a.in[1]; const float* rstd0 = (const float*)(a.ws + WS_RSTD0); bf16* D = (bf16*)(a.ws + WS_D);
    for (int it = F.vcu; it < 1024; it += F.G) {
        const int half = it & 1, run = (it >> 1) & 63, b = it >> 7;
        const int c = half * 2048 + F.tid * 4, grp = c >> 10, wh = 1 << grp, t0 = run * 32;
        const f32x4 gv = *(const f32x4*)(gmix + c);
        const float* xb = x + (size_t)b * SEQ * DM + c; const float* rb = rstd0 + b * SEQ;
        f32x4 s = {0.f, 0.f, 0.f, 0.f};
        const int lo0 = (t0 - wh) > 0 ? (t0 - wh) : 0, hi0 = (t0 + wh) < SEQ ? (t0 + wh) : SEQ;
        for (int u = lo0; u < hi0; ++u) s += *(const f32x4*)(xb + (size_t)u * DM) * rb[u];
        for (int t = t0; t < t0 + 32; ++t) {
            const int lo = (t - wh) > 0 ? (t - wh) : 0, hi = (t + wh) < SEQ ? (t + wh) : SEQ;
            const float inv = 1.0f / (float)(hi - lo);
            const f32x4 cen = *(const f32x4*)(xb + (size_t)t * DM) * rb[t];
            const f32x4 d = (s * inv - cen) * gv;
            v2u w; w.x = pk2(d.x, d.y); w.y = pk2(d.z, d.w);
            *(v2u*)(D + ((size_t)(b * SEQ + t)) * DM + c) = w;
            if (t + wh < SEQ) s += *(const f32x4*)(xb + (size_t)(t + wh) * DM) * rb[t + wh];
            if (t - wh >= 0) s -= *(const f32x4*)(xb + (size_t)(t - wh) * DM) * rb[t - wh];
        }
    }
}

#define HD __host__ __device__ __forceinline__
HD int qt_off(int p, int dk) { const int s = dk >> 5, r = dk & 31, a = r >> 4, q = (r >> 2) & 3, i = r & 3; return (((s * 4 + (p >> 4)) * 64) + (p & 15) + 16 * q) * 16 + (4 * a + i) * 2; }
HD int kt_off(int dk, int p) { return ((((dk >> 4) * 2 + (p >> 5)) * 64) + (dk & 15) + 16 * ((p >> 3) & 3)) * 16 + (p & 7) * 2; }
HD int pa_off(int i, int j) { return ((((i >> 4) * 2 + (j >> 5)) * 64) + (i & 15) + 16 * ((j >> 3) & 3)) * 16 + (j & 7) * 2; }
HD int vslot(int p) { return (p & 0x33) | (((p >> 3) & 1) << 2) | (((p >> 2) & 1) << 3); }
HD int v_off(int p, int dvl) { return (dvl >> 4) * 2048 + vslot(p) * 32 + (dvl & 15) * 2; }

typedef float f32x2_t __attribute__((ext_vector_type(2))); typedef __bf16 bf16x2_t __attribute__((ext_vector_type(2)));
typedef short v4i16_t __attribute__((ext_vector_type(4)));
__device__ __forceinline__ unsigned cvtpk(float lo, float hi) { f32x2_t v = {lo, hi}; bf16x2_t b = __builtin_convertvector(v, bf16x2_t); return __builtin_bit_cast(unsigned, b); }
__device__ __forceinline__ float dpp_row_shr(float v, int n) {
    const int iv = __builtin_bit_cast(int, v); int r;
    switch (n) { case 1: r = __builtin_amdgcn_update_dpp(0, iv, 0x111, 0xf, 0xf, true); break; case 2: r = __builtin_amdgcn_update_dpp(0, iv, 0x112, 0xf, 0xf, true); break;
                 case 4: r = __builtin_amdgcn_update_dpp(0, iv, 0x114, 0xf, 0xf, true); break; default: r = __builtin_amdgcn_update_dpp(0, iv, 0x118, 0xf, 0xf, true); break; }
    return __builtin_bit_cast(float, r);
}
__device__ __forceinline__ float wave_scan_incl(float v) {
    v += dpp_row_shr(v, 1); v += dpp_row_shr(v, 2); v += dpp_row_shr(v, 4); v += dpp_row_shr(v, 8);
    v += __builtin_bit_cast(float, __builtin_amdgcn_update_dpp(0, __builtin_bit_cast(int, v), 0x142, 0xa, 0xf, false));
    v += __builtin_bit_cast(float, __builtin_amdgcn_update_dpp(0, __builtin_bit_cast(int, v), 0x143, 0xc, 0xf, false));
    return v;
}
__device__ __forceinline__ float rdlane(float v, int l) { return __builtin_bit_cast(float, __builtin_amdgcn_readlane(__builtin_bit_cast(int, v), l)); }
#define GLDS16(src, dst) __builtin_amdgcn_global_load_lds((const unsigned*)(src), (LAS unsigned*)(dst), 16, 0, 0)

__device__ __forceinline__ void phase_gla_prep(Frame& F, const Args& a) {
    unsigned char* ws = a.ws;
    const bf16* Qb = (const bf16*)(ws + WS_Q); const bf16* Kb = (const bf16*)(ws + WS_K); const float* R = (const float*)(ws + WS_R);
    LAS unsigned char* QS = F.lds; LAS unsigned char* KS = F.lds + 65536; LAS unsigned char* scr = F.lds + 131072 + F.wave * 1024;
    const int w = F.wave, p = F.lane;
    const float qscale = 0.044194173824159216f;
    for (int item = F.vcu; item < BATCH * NH * 2 * 32; item += F.G) {
        const int c = item & 31, dir = (item >> 5) & 1, h = (item >> 6) & 3, b = item >> 8;
        const int tok = b * SEQ + 64 * c + (dir ? 63 - p : p);
        const float* wup = a.in[dir ? 9 : 7] + h * HK + 64 * w;
        const float* bup = a.in[dir ? 10 : 8] + h * HK + 64 * w;
        unsigned char* QTi = ws + WS_QT + (size_t)item * 65536; unsigned char* KTi = ws + WS_KT + (size_t)item * 65536; unsigned char* PAi = ws + WS_PA + (size_t)item * 10240;
        float* ach = (float*)(PAi + 8192);
        f32x4 rv[4];
#pragma unroll
        for (int j = 0; j < 4; ++j) rv[j] = *(const f32x4*)(R + (size_t)tok * 32 + dir * 16 + 4 * j);
        v4u qraw[8], kraw[8];
#pragma unroll
        for (int j = 0; j < 8; ++j) { qraw[j] = *(const v4u*)(Qb + (size_t)tok * KD + h * HK + 64 * w + 8 * j); kraw[j] = *(const v4u*)(Kb + (size_t)tok * KD + h * HK + 64 * w + 8 * j); }
#pragma unroll
        for (int sl = 0; sl < 2; ++sl)
#pragma unroll
            for (int q = 0; q < 4; ++q) {
                const int s = 2 * w + sl, dl = 32 * sl + 4 * q;
                float x[8];
                { const f32x4 b0 = *(const f32x4*)(bup + dl), b1 = *(const f32x4*)(bup + dl + 16);
                  x[0] = b0.x; x[1] = b0.y; x[2] = b0.z; x[3] = b0.w; x[4] = b1.x; x[5] = b1.y; x[6] = b1.z; x[7] = b1.w; }
#pragma unroll
                for (int r = 0; r < 16; ++r) { const f32x4 w0 = *(const f32x4*)(wup + r * KD + dl), w1 = *(const f32x4*)(wup + r * KD + dl + 16); const float rr = rv[r >> 2][r & 3];
                    x[0] += rr * w0.x; x[1] += rr * w0.y; x[2] += rr * w0.z; x[3] += rr * w0.w; x[4] += rr * w1.x; x[5] += rr * w1.y; x[6] += rr * w1.z; x[7] += rr * w1.w; }
                float qv[8], kv[8];
#pragma unroll
                for (int aa = 0; aa < 2; ++aa) { const v4u qc = qraw[4 * sl + 2 * aa + (q >> 1)], kc = kraw[4 * sl + 2 * aa + (q >> 1)];
                    const unsigned q01 = (q & 1) ? qc.z : qc.x, q23 = (q & 1) ? qc.w : qc.y, k01 = (q & 1) ? kc.z : kc.x, k23 = (q & 1) ? kc.w : kc.y;
                    qv[4 * aa + 0] = bf2f((unsigned short)(q01 & 0xffffu)); qv[4 * aa + 1] = bf2f((unsigned short)(q01 >> 16)); qv[4 * aa + 2] = bf2f((unsigned short)(q23 & 0xffffu)); qv[4 * aa + 3] = bf2f((unsigned short)(q23 >> 16));
                    kv[4 * aa + 0] = bf2f((unsigned short)(k01 & 0xffffu)); kv[4 * aa + 1] = bf2f((unsigned short)(k01 >> 16)); kv[4 * aa + 2] = bf2f((unsigned short)(k23 & 0xffffu)); kv[4 * aa + 3] = bf2f((unsigned short)(k23 >> 16)); }
                float qs_[8], ks_[8], qt_[8], kt_[8], al[8];
#pragma unroll
                for (int e = 0; e < 8; ++e) {
                    const float ls = fminf(x[e], 0.f) - __logf(1.0f + __expf(-fabsf(x[e])));
                    const float bc = wave_scan_incl(ls * (1.0f / 16.0f));
                    const float bm = rdlane(bc, 31), bl = rdlane(bc, 63);
                    const float eb = __expf(bc - bm), ebi = __expf(bm - bc), em = __expf(bm), elm = __expf(bl - bm);
                    qs_[e] = qv[e] * qscale * eb; ks_[e] = kv[e] * ebi; qt_[e] = qs_[e] * em; kt_[e] = ks_[e] * elm; al[e] = __expf(bl);
                }
                const int off16 = (((s * 4 + (p >> 4)) * 64) + (p & 15) + 16 * q) * 16;
                { v4u t; t.x = cvtpk(qt_[0], qt_[1]); t.y = cvtpk(qt_[2], qt_[3]); t.z = cvtpk(qt_[4], qt_[5]); t.w = cvtpk(qt_[6], qt_[7]); *(GAS v4u*)(QTi + off16) = t; }
                { v4u t; t.x = cvtpk(qs_[0], qs_[1]); t.y = cvtpk(qs_[2], qs_[3]); t.z = cvtpk(qs_[4], qs_[5]); t.w = cvtpk(qs_[6], qs_[7]); *(LAS v4u*)(QS + off16) = t; }
                { v4u t; t.x = cvtpk(ks_[0], ks_[1]); t.y = cvtpk(ks_[2], ks_[3]); t.z = cvtpk(ks_[4], ks_[5]); t.w = cvtpk(ks_[6], ks_[7]); *(LAS v4u*)(KS + off16) = t; }
                if (p == 63) { *(f32x4*)(ach + 32 * s + 4 * q) = (f32x4){al[0], al[1], al[2], al[3]}; *(f32x4*)(ach + 32 * s + 16 + 4 * q) = (f32x4){al[4], al[5], al[6], al[7]}; }
                asm volatile("" ::: "memory");
#pragma unroll
                for (int e = 0; e < 8; ++e) *(LAS unsigned short*)(scr + e * 128 + p * 2) = (unsigned short)(cvtpk(kt_[e], 0.f) & 0xffffu);
                asm volatile("s_waitcnt lgkmcnt(0)" ::: "memory");
                { const int e2 = p >> 3, n = p & 7; const v4u kk = *(const LAS v4u*)(scr + e2 * 128 + n * 16);
                  const int dk = 32 * s + 16 * (e2 >> 2) + 4 * q + (e2 & 3);
                  asm volatile("s_waitcnt lgkmcnt(0)" ::: "memory");
                  *(GAS v4u*)(KTi + kt_off(dk, 8 * n)) = kk; }
            }
        __syncthreads();
        {
            const int mj = w >> 1, mi0 = 2 * (w & 1), fr = p & 15, fq = p >> 4;
            f32x4 acc0 = {0.f, 0.f, 0.f, 0.f}, acc1 = {0.f, 0.f, 0.f, 0.f};
#pragma unroll
            for (int s = 0; s < 16; ++s) {
                const bf16x8 A = *(const LAS bf16x8*)(KS + ((s * 4 + mj) * 64 + p) * 16);
                const bf16x8 B0 = *(const LAS bf16x8*)(QS + ((s * 4 + mi0) * 64 + p) * 16), B1 = *(const LAS bf16x8*)(QS + ((s * 4 + mi0 + 1) * 64 + p) * 16);
                acc0 = __builtin_amdgcn_mfma_f32_16x16x32_bf16(A, B0, acc0, 0, 0, 0); acc1 = __builtin_amdgcn_mfma_f32_16x16x32_bf16(A, B1, acc1, 0, 0, 0);
            }
            const int j0 = 16 * mj + 4 * fq;
            { const int i = 16 * mi0 + fr; v2u t; t.x = cvtpk(j0 <= i ? acc0[0] : 0.f, j0 + 1 <= i ? acc0[1] : 0.f); t.y = cvtpk(j0 + 2 <= i ? acc0[2] : 0.f, j0 + 3 <= i ? acc0[3] : 0.f); *(GAS v2u*)(PAi + pa_off(i, j0)) = t; }
            { const int i = 16 * (mi0 + 1) + fr; v2u t; t.x = cvtpk(j0 <= i ? acc1[0] : 0.f, j0 + 1 <= i ? acc1[1] : 0.f); t.y = cvtpk(j0 + 2 <= i ? acc1[2] : 0.f, j0 + 3 <= i ? acc1[3] : 0.f); *(GAS v2u*)(PAi + pa_off(i, j0)) = t; }
        }
        __syncthreads();
    }
}

constexpr int SCAN_SUB = 32768, SCAN_PV = 26624, SCAN_PV_OFF = 3 * SCAN_SUB;
__device__ __forceinline__ void scan_issue_sub(LAS unsigned char* dst, const unsigned char* ws, int bh, int i, int w, int lane) {
    const int cs = i >> 2, j = i & 3, dir = cs >> 5, cc = cs & 31, c = dir ? 31 - cc : cc;
    const size_t item = (size_t)((bh * 2 + dir) * 32 + c);
    const unsigned char* qsrc = ws + WS_QT + item * 65536 + j * 16384 + lane * 16; const unsigned char* ksrc = ws + WS_KT + item * 65536 + j * 16384 + lane * 16;
    GLDS16(qsrc + w * 1024, dst + w * 1024); GLDS16(qsrc + (w + 8) * 1024, dst + (w + 8) * 1024);
    GLDS16(ksrc + w * 1024, dst + 16384 + w * 1024); GLDS16(ksrc + (w + 8) * 1024, dst + 16384 + (w + 8) * 1024);
}
__device__ __forceinline__ void scan_issue_pv(LAS unsigned char* slot, const unsigned char* ws, int b, int h, int sl, int cs, int k, int w, int lane) {
    const int dir = cs >> 5, cc = cs & 31, c = dir ? 31 - cc : cc;
    const size_t item = (size_t)(((b * 4 + h) * 2 + dir) * 32 + c);
    int idx = w + 8 * k; if (idx >= 26) idx -= 8;
    const unsigned char* src;
    if (idx < 10) src = ws + WS_PA + item * 10240 + idx * 1024 + lane * 16;
    else { const int kk = idx - 10, wblk = kk >> 1, slt = (kk & 1) * 32 + (lane >> 1), half = lane & 1, p = vslot(slt);
           const int tok = b * SEQ + 64 * c + (dir ? 63 - p : p);
           src = ws + WS_V + ((size_t)tok * VD + h * HV + 128 * sl + 16 * wblk + 8 * half) * 2; }
    GLDS16(src, slot + idx * 1024);
}
__device__ __forceinline__ void phase_gla_scan(Frame& F, const Args& a) {
    const unsigned char* ws = a.ws;
    LAS unsigned char* RING = F.lds; LAS unsigned char* PVS = F.lds + SCAN_PV_OFF;
    const int w = F.wave, lane = F.lane, fr = lane & 15, fq = lane >> 4;
    for (int u = F.vcu; u < BATCH * NH * 8; u += F.G) {
        const int sl = u & 7, h = (u >> 3) & 3, b = u >> 5, bh = b * 4 + h;
        f32x4 S[32];
#pragma unroll
        for (int t = 0; t < 32; ++t) S[t] = (f32x4){0.f, 0.f, 0.f, 0.f};
#pragma unroll
        for (int k = 0; k < 4; ++k) scan_issue_pv(PVS, ws, b, h, sl, 0, k, w, lane);
        scan_issue_sub(RING, ws, bh, 0, w, lane); scan_issue_sub(RING + SCAN_SUB, ws, bh, 1, w, lane);
        asm volatile("s_waitcnt vmcnt(4)" ::: "memory"); __builtin_amdgcn_s_barrier();
        int r3 = 0;
        for (int cs = 0; cs < 64; ++cs) {
            const int dir = cs >> 5, cc = cs & 31, c = dir ? 31 - cc : cc;
            if (cs == 32) {
#pragma unroll
                for (int t = 0; t < 32; ++t) S[t] = (f32x4){0.f, 0.f, 0.f, 0.f};
            }
            LAS unsigned char* pv = PVS + (cs & 1) * SCAN_PV;
            LAS unsigned char* pvn = PVS + ((cs + 1) & 1) * SCAN_PV;
            const int ncs = cs + 1 < 64 ? cs + 1 : 63;
            f32x4 o[4]; bf16x8 vB[2];
#pragma unroll
            for (int j = 0; j < 4; ++j) {
                if (j == 0) asm volatile("s_waitcnt vmcnt(20)" ::: "memory"); else asm volatile("s_waitcnt vmcnt(4)" ::: "memory");
                __builtin_amdgcn_s_barrier(); __builtin_amdgcn_sched_barrier(0);
                {
                    scan_issue_pv(pvn, ws, b, h, sl, ncs, j, w, lane);
                    int i2 = 4 * cs + j + 2; if (i2 > 255) i2 = 255;
                    int s3 = r3 + ((j + 2) % 3); if (s3 >= 3) s3 -= 3;
                    scan_issue_sub(RING + s3 * SCAN_SUB, ws, bh, i2, w, lane);
                }
                int c3 = r3 + (j % 3); if (c3 >= 3) c3 -= 3;
                LAS unsigned char* rb = RING + c3 * SCAN_SUB;
                if (j == 0) {
#pragma unroll
                    for (int m = 0; m < 4; ++m) o[m] = (f32x4){0.f, 0.f, 0.f, 0.f};
#pragma unroll
                    for (int s2 = 0; s2 < 2; ++s2) {
                        const LAS unsigned char* vb = pv + 10240 + w * 2048 + (fr & 3) * 8;
                        const v4i16_t lo = __builtin_amdgcn_ds_read_tr16_b64_v4i16((LAS v4i16_t*)(vb + vslot(32 * s2 + 8 * fq + (fr >> 2)) * 32));
                        const v4i16_t hi = __builtin_amdgcn_ds_read_tr16_b64_v4i16((LAS v4i16_t*)(vb + vslot(32 * s2 + 8 * fq + 4 + (fr >> 2)) * 32));
                        vB[s2] = __builtin_shufflevector(lo, hi, 0, 1, 2, 3, 4, 5, 6, 7);
                    }
#pragma unroll
                    for (int m = 0; m < 4; ++m)
#pragma unroll
                        for (int s2 = 0; s2 < 2; ++s2) o[m] = __builtin_amdgcn_mfma_f32_16x16x32_bf16(*(const LAS bf16x8*)(pv + ((m * 2 + s2) * 64 + lane) * 16), vB[s2], o[m], 0, 0, 0);
                }
#pragma unroll
                for (int ss = 0; ss < 4; ++ss) {
                    const int t0 = 8 * j + 2 * ss;
                    v4u pk; pk.x = cvtpk(S[t0][0], S[t0][1]); pk.y = cvtpk(S[t0][2], S[t0][3]); pk.z = cvtpk(S[t0 + 1][0], S[t0 + 1][1]); pk.w = cvtpk(S[t0 + 1][2], S[t0 + 1][3]);
                    const bf16x8 Bs = __builtin_bit_cast(bf16x8, pk);
#pragma unroll
                    for (int m = 0; m < 4; ++m) o[m] = __builtin_amdgcn_mfma_f32_16x16x32_bf16(*(const LAS bf16x8*)(rb + ((ss * 4 + m) * 64 + lane) * 16), Bs, o[m], 0, 0, 0);
                }
#pragma unroll
                for (int tl = 0; tl < 8; ++tl) {
                    const int t = 8 * j + tl;
                    const f32x4 a4 = *(const LAS f32x4*)(pv + 8192 + (128 * j + 16 * tl + 4 * fq) * 4);
                    S[t] = S[t] * a4;
#pragma unroll
                    for (int s2 = 0; s2 < 2; ++s2) S[t] = __builtin_amdgcn_mfma_f32_16x16x32_bf16(*(const LAS bf16x8*)(rb + 16384 + ((tl * 2 + s2) * 64 + lane) * 16), vB[s2], S[t], 0, 0, 0);
                }
                if (j == 3) {
                    float* Od = (float*)(a.ws + (dir ? WS_OB : WS_OF)) + (size_t)h * HV + 128 * sl + 16 * w + fr;
#pragma unroll
                    for (int m = 0; m < 4; ++m)
#pragma unroll
                        for (int r = 0; r < 4; ++r) { const int p = 16 * m + 4 * fq + r; const int tok = b * SEQ + 64 * c + (dir ? 63 - p : p); Od[(size_t)tok * VD] = o[m][r]; }
                }
            }
            r3 = r3 + 1; if (r3 == 3) r3 = 0;
        }
        asm volatile("s_waitcnt vmcnt(0)" ::: "memory"); __builtin_amdgcn_s_barrier();
    }
}

__device__ __forceinline__ void phase_post(Frame& F, const Args& a) {
    const float* O = (const float*)(a.ws + WS_OF); const float* O2 = (const float*)(a.ws + WS_OB); const bf16* Gt = (const bf16*)(a.ws + WS_G); bf16* XA = (bf16*)(a.ws + WS_D); const float* gn = a.in[11];
    const int gw = F.vcu * 8 + F.wave, NGW = F.G * 8;
    f32x4 gv[4];
#pragma unroll
    for (int j = 0; j < 4; ++j) gv[j] = *(const f32x4*)(gn + F.lane * 4 + 256 * j);
    for (int it = gw; it < M * NH; it += NGW) {
        const size_t base = (size_t)(it >> 2) * VD + (it & 3) * HV + F.lane * 4;
        f32x4 o[4]; float s = 0.f;
#pragma unroll
        for (int j = 0; j < 4; ++j) { o[j] = *(const f32x4*)(O + base + 256 * j) + *(const f32x4*)(O2 + base + 256 * j); s += (o[j].x * o[j].x + o[j].y * o[j].y) + (o[j].z * o[j].z + o[j].w * o[j].w); }
        s = wave_sum(s); const float rs = 1.0f / sqrtf(s * (1.0f / HV) + EPS);
#pragma unroll
        for (int j = 0; j < 4; ++j) {
            const v2u gw2 = *(const v2u*)(Gt + base + 256 * j);
            const float g0 = bf2f((unsigned short)(gw2.x & 0xffffu)), g1 = bf2f((unsigned short)(gw2.x >> 16)), g2 = bf2f((unsigned short)(gw2.y & 0xffffu)), g3 = bf2f((unsigned short)(gw2.y >> 16));
            const f32x4 y = o[j] * rs * gv[j];
            const float r0 = y.x * g0 / (1.0f + __expf(-g0)), r1 = y.y * g1 / (1.0f + __expf(-g1)), r2 = y.z * g2 / (1.0f + __expf(-g2)), r3 = y.w * g3 / (1.0f + __expf(-g3));
            v2u w; w.x = pk2(r0, r1); w.y = pk2(r2, r3);
            *(v2u*)(XA + base + 256 * j) = w;
        }
    }
}
__device__ __forceinline__ void phase_final(Frame& F, const Args& a) {
    float* H = a.out; const float* ss = (const float*)(a.ws + WS_CTL) + CW_SS + 3 * M; const float* gf = a.in[3];
    const int gw = F.vcu * 8 + F.wave, NGW = F.G * 8;
    for (int m = gw; m < M; m += NGW) {
        const float rs = 1.0f / sqrtf(ld_agent(ss + m) * (1.0f / DM) + EPS);
        f32x4* hr = (f32x4*)(H + (size_t)m * DM) + F.lane;
#pragma unroll
        for (int j = 0; j < 16; ++j) { const f32x4 g = *((const f32x4*)gf + F.lane + 64 * j); hr[64 * j] = hr[64 * j] * rs * g; }
    }
}

__global__ void __launch_bounds__(512, 2) mk_fwd(Args args) {
    extern __shared__ __attribute__((aligned(16))) unsigned char lds[];
    Frame F;
    F.lds = (LAS unsigned char*)lds;
    F.tid = threadIdx.x; F.lane = F.tid & 63; F.wave = __builtin_amdgcn_readfirstlane(F.tid >> 6);
    F.G = gridDim.x; { const int bx = blockIdx.x; F.vcu = (F.G % 8 == 0) ? (bx % 8) * (F.G / 8) + bx / 8 : bx; }
    volatile LAS unsigned* MISC = (volatile LAS unsigned*)(F.lds + MISC_OFF);
    if (F.tid < 64) MISC[F.tid] = 0u;
    __syncthreads();
    unsigned char* ws = args.ws;
    unsigned* ctl = (unsigned*)(ws + WS_CTL);
    const int lo = args.ph_lo, hi = args.ph_hi;
    XcdBarrier bar; bar.bar = ctl + CW_BAR; bar.x = 0; bar.st = nullptr;
    if (hi - lo > 1) bar = xcd_barrier_post(ctl + CW_BAR, MISC + 8);
#define IN(k) (lo <= (k) && (k) < hi)
#define SEAM(k) do { if (IN(k) && IN((k) + 1)) xcd_barrier(bar); } while (0)
    float* SS = (float*)ctl + CW_SS;
    float* H = args.out;
    bf16* XN = (bf16*)(ws + WS_XN); bf16* Db = (bf16*)(ws + WS_D); bf16* HID = (bf16*)(ws + WS_HID);
    const float* norm_mix = args.in[1]; const float* norm_mlp = args.in[2];

    if (IN(0)) { phase_prologue(F, args); } SEAM(0);
    if (IN(1)) { phase_pooldiff(F, args); } SEAM(1);
    if (IN(2)) {
        pg8::Gemm g{Db, (const bf16*)(ws + WS_WPOOL), M, DM, 1024, DM, 4}; pg8::StaticOrder S; S.init(M, DM, F.G, (int)blockIdx.x);
        pg8::EpiResid E{args.in[0], H, args.in[5], norm_mlp, XN, SS + 0 * M, DM};
        pg8::gemm_phase<pg8::EpiResid, pg8::StaticOrder>(F.lds, g, S, E);
    } SEAM(2);
    if (IN(3)) {
        pg8::Gemm g{XN, (const bf16*)(ws + WS_W1_0), M, FF, DM, DM, 0}; pg8::StaticOrder S; S.init(M, FF, F.G, (int)blockIdx.x);
        pg8::EpiRelu2 E{HID, FF, SS + 0 * M};
        pg8::gemm_phase<pg8::EpiRelu2, pg8::StaticOrder>(F.lds, g, S, E);
    } SEAM(3);
    if (IN(4)) {
        pg8::Gemm g{HID, (const bf16*)(ws + WS_W2_0), M, DM, FF, FF, 0}; pg8::StaticOrder S; S.init(M, DM, F.G, (int)blockIdx.x);
        pg8::EpiResid E{H, H, nullptr, norm_mix + DM, XN, SS + 1 * M, DM};
        pg8::gemm_phase<pg8::EpiResid, pg8::StaticOrder>(F.lds, g, S, E);
    } SEAM(4);
    if (IN(5)) {
        pg8::Gemm g{XN, (const bf16*)(ws + WS_WIN), M, PWP, DM, DM, 0}; pg8::StaticOrder S; S.init(M, PWP, F.G, (int)blockIdx.x);
        pg8::EpiInProj E{(bf16*)(ws + WS_Q), (bf16*)(ws + WS_K), (bf16*)(ws + WS_V), (bf16*)(ws + WS_G), (float*)(ws + WS_R), SS + 1 * M};
        pg8::gemm_phase<pg8::EpiInProj, pg8::StaticOrder>(F.lds, g, S, E);
    } SEAM(5);
    if (IN(6)) { phase_gla_prep(F, args); } SEAM(6);
    if (IN(7)) { phase_gla_scan(F, args); } SEAM(7);
    if (IN(8)) { phase_post(F, args); } SEAM(8);
    if (IN(9)) {
        pg8::Gemm g{Db, (const bf16*)(ws + WS_WOUT), M, DM, VD, VD, 0}; pg8::StaticOrder S; S.init(M, DM, F.G, (int)blockIdx.x);
        pg8::EpiResid E{H, H, nullptr, norm_mlp + DM, XN, SS + 2 * M, DM};
        pg8::gemm_phase<pg8::EpiResid, pg8::StaticOrder>(F.lds, g, S, E);
    } SEAM(9);
    if (IN(10)) {
        pg8::Gemm g{XN, (const bf16*)(ws + WS_W1_1), M, FF, DM, DM, 0}; pg8::StaticOrder S; S.init(M, FF, F.G, (int)blockIdx.x);
        pg8::EpiRelu2 E{HID, FF, SS + 2 * M};
        pg8::gemm_phase<pg8::EpiRelu2, pg8::StaticOrder>(F.lds, g, S, E);
    } SEAM(10);
    if (IN(11)) {
        pg8::Gemm g{HID, (const bf16*)(ws + WS_W2_1), M, DM, FF, FF, 0}; pg8::StaticOrder S; S.init(M, DM, F.G, (int)blockIdx.x);
        pg8::EpiResid E{H, H, nullptr, nullptr, nullptr, SS + 3 * M, DM};
        pg8::gemm_phase<pg8::EpiResid, pg8::StaticOrder>(F.lds, g, S, E);
    } SEAM(11);
    if (IN(12)) { phase_final(F, args); }
#undef IN
#undef SEAM
}

extern "C" void kernel_launch(void* const* d_in, const int* in_sizes, int n_in, void* d_out, int out_size, void* d_ws, size_t ws_size, hipStream_t stream) {
    static int grid = 0;
    if (grid == 0) {
        if (n_in != 15 || in_sizes[0] != M * DM || out_size != M * DM || ws_size < WS_END) {
            fprintf(stderr, "kernel_launch: unexpected problem (n_in %d, in0 %d, out %d, ws %zu < %zu); nothing launched\n", n_in, n_in > 0 ? in_sizes[0] : -1, out_size, ws_size, (size_t)WS_END); grid = -1; return; }
        int dev = 0, cus = 0;
        if (hipGetDevice(&dev) != hipSuccess || hipDeviceGetAttribute(&cus, hipDeviceAttributeMultiprocessorCount, dev) != hipSuccess) { grid = -1; return; }
        if (hipFuncSetAttribute((const void*)mk_fwd, hipFuncAttributeMaxDynamicSharedMemorySize, LDS_BYTES) != hipSuccess) { fprintf(stderr, "kernel_launch: hipFuncSetAttribute failed\n"); grid = -1; return; }
        int per_cu = 0;
        if (hipOccupancyMaxActiveBlocksPerMultiprocessor(&per_cu, (const void*)mk_fwd, 512, LDS_BYTES) != hipSuccess || per_cu < 1) fprintf(stderr, "kernel_launch: occupancy query says %d\n", per_cu);
        (void)hipGetLastError();
        grid = cus;
    }
    if (grid < 0) return;
    (void)hipMemsetAsync((char*)d_ws + WS_CTL, 0, CTL_ZERO_BYTES, stream);
    Args a{};
    for (int i = 0; i < 15; ++i) a.in[i] = (const float*)d_in[i];
    a.out = (float*)d_out; a.ws = (unsigned char*)d_ws;
#if MK_PER_PHASE
    for (int p = 0; p < NPHASE; ++p) { a.ph_lo = p; a.ph_hi = p + 1; hipLaunchKernelGGL(mk_fwd, dim3(grid), dim3(512), LDS_BYTES, stream, a); }
#else
    a.ph_lo = 0; a.ph_hi = NPHASE; hipLaunchKernelGGL(mk_fwd, dim3(grid), dim3(512), LDS_BYTES, stream, a);
#endif
}
```

```cpp
#include <hip/hip_runtime.h>
#include <cstdio>
#include <cstdint>

#ifndef MK_PER_PHASE
#define MK_PER_PHASE 0
#endif
#ifndef PROBE_MASK
#define PROBE_MASK 0u
#endif

constexpr int BATCH = 8, SEQ = 2048, DM = 4096, M = BATCH * SEQ, FF = 4 * DM;
constexpr int NH = 4, KD = DM / 2, VD = DM, HK = KD / NH, HV = VD / NH, GR = 16;
constexpr int PW = 2 * KD + 2 * VD + 2 * GR;
constexpr int PWP = 12544;
constexpr float EPS = 1e-6f;
constexpr int NPHASE = 17;

constexpr size_t MiB = 1u << 20;
constexpr size_t WS_CTL = 0, CTL_ZERO_BYTES = 1 * MiB;
constexpr size_t WS_WPOOL = 2 * MiB;
constexpr size_t WS_WOUT = 10 * MiB;
constexpr size_t WS_WIN = 42 * MiB;
constexpr size_t WS_W1_0 = 140 * MiB, WS_W1_1 = 396 * MiB;
constexpr size_t WS_W2_0 = 268 * MiB, WS_W2_1 = 524 * MiB;
constexpr size_t WS_OB = 140 * MiB;
constexpr size_t WS_XN = 652 * MiB;
constexpr size_t WS_D = 780 * MiB;
constexpr size_t WS_HID = 908 * MiB;
constexpr size_t WS_Q = 908 * MiB;
constexpr size_t WS_K = 972 * MiB;
constexpr size_t WS_V = 1036 * MiB;
constexpr size_t WS_G = 1164 * MiB;
constexpr size_t WS_R = 1292 * MiB;
constexpr size_t WS_QT = 1294 * MiB;
constexpr size_t WS_KT = 1422 * MiB;
constexpr size_t WS_PA = 1550 * MiB;
constexpr size_t WS_OF = 1570 * MiB;
constexpr size_t WS_HIDQ = 1550 * MiB;
constexpr size_t WS_RSTD0 = 1826 * MiB;
constexpr size_t WS_RS = WS_RSTD0 + 65536, WS_CS = WS_RSTD0 + 262144;
constexpr size_t WS_END = 1827 * MiB;
constexpr int CW_BAR = 4096;
constexpr int CW_PAN = 12288;
constexpr int CW_W2MAX = 245760;
constexpr int CW_W2SUM = 253952;
constexpr int CW_SS = 131072;

constexpr int LDS_BYTES = 159 * 1024;
constexpr int RING_BYTES = 131072;
constexpr int MISC_OFF = LDS_BYTES - 256;

#define GAS __attribute__((address_space(1)))
#define LAS __attribute__((address_space(3)))
typedef unsigned short bf16;
typedef unsigned v4u __attribute__((ext_vector_type(4)));
typedef unsigned v2u __attribute__((ext_vector_type(2)));
typedef float f32x4 __attribute__((ext_vector_type(4)));
typedef short bf16x8 __attribute__((ext_vector_type(8)));
typedef int i32x4 __attribute__((ext_vector_type(4)));
#define LDS_WAIT() asm volatile("s_waitcnt lgkmcnt(0)" ::: "memory")
#define VM_WAIT() asm volatile("s_waitcnt vmcnt(0)" ::: "memory")
__device__ __forceinline__ unsigned f2bf(float f) { unsigned u = __builtin_bit_cast(unsigned, f); return (u + 0x7fffu + ((u >> 16) & 1u)) >> 16; }
__device__ __forceinline__ unsigned pk2(float lo, float hi) { return f2bf(lo) | (f2bf(hi) << 16); }
__device__ __forceinline__ float bf2f(unsigned short b) { return __builtin_bit_cast(float, ((unsigned)b) << 16); }
__device__ __forceinline__ float ld_agent(const float* p) { return __builtin_bit_cast(float, __hip_atomic_load((const unsigned*)p, __ATOMIC_RELAXED, __HIP_MEMORY_SCOPE_AGENT)); }

namespace pg8 {
#define PG8_LAS __attribute__((address_space(3)))
typedef unsigned short bf16_t;
typedef unsigned u32x4 __attribute__((ext_vector_type(4)));
constexpr int BM = 256, BK = 64, HALF = 128, HTB = HALF * BK * 2, STAGE_BYTES = 8 * HTB, NXCD = 8, WGM = 8;

__host__ __device__ __forceinline__ int lds_byte(int r, int c) { const int st = (r >> 4) * 2 + (c >> 5), rr = r & 15, cc = c & 31, ob = rr * 64 + cc * 2; return st * 1024 + (ob ^ (((ob >> 9) & 1) << 5)); }
__host__ __device__ __forceinline__ void stage_rc(int b, int& R, int& C) { const int st = b / 1024, sb = b % 1024, swz = sb ^ (((sb >> 9) & 1) << 5); R = (st >> 1) * 16 + swz / 64; C = (st & 1) * 32 + (swz % 64) / 2; }
__host__ __device__ __forceinline__ int perm32(int rho) { const int n = rho >> 4, i = rho & 15; return 8 * (i >> 2) + 4 * n + (i & 3); }

struct Unit { int pm, pn; };
struct Gemm { const bf16_t* A; const bf16_t* Bt; int M, N, K, lda, grp; };

struct StaticOrder {
    int nM, nN, nwg, G, c;
    __host__ __device__ void init(int M_, int N_, int G_, int c_) { nM = M_ / BM; nN = N_ / BM; nwg = nM * nN; G = G_; c = c_; }
    __host__ __device__ bool next(int i, Unit& u) const {
        const long L = (long)i * G + c; if (L >= nwg) return false;
        int wgid = (int)L; { const int q = nwg / NXCD, r = nwg % NXCD, xcd = wgid % NXCD, off = wgid / NXCD; wgid = (xcd < r ? xcd * (q + 1) : r * (q + 1) + (xcd - r) * q) + off; }
        const int nig = WGM * nN, gid = wgid / nig, fm = gid * WGM, gsz = (nM - fm) < WGM ? (nM - fm) : WGM;
        u.pm = fm + ((wgid % nig) % gsz); u.pn = (wgid % nig) / gsz; return true;
    }
    __device__ __forceinline__ void a_ready(const Unit&) const {}
    __device__ __forceinline__ void done(const Unit&) const {}
};

__device__ __forceinline__ unsigned cvt_pk_bf16(float lo, float hi) { unsigned r; asm volatile("v_cvt_pk_bf16_f32 %0, %1, %2" : "=v"(r) : "v"(lo), "v"(hi)); return r; }


struct EpiResid {
    static constexpr bool PERM = true, AFTER_DRAIN = false;
    const float* hin; float* hout; const float* cscale; const float* gnext; bf16_t* xn; float* ss; int ldc; int deep;
    __device__ __forceinline__ void pre(const Unit&, int, int, float (&p)[8]) const { _Pragma("unroll") for (int i = 0; i < 8; ++i) p[i] = 0.f; }
    __device__ __forceinline__ void operator()(const f32x4 (&acc)[2][2][4][2], const Unit& u, int wr, int wc, int fr, int fq, const float (&)[8]) const {
        const int row0 = u.pm * BM + wr * 64 + fr, col0 = u.pn * BM + wc * 32 + 8 * fq;
        f32x4 sc[2][2], gn[2][2];
#pragma unroll
        for (int bj = 0; bj < 2; ++bj)
#pragma unroll
            for (int n = 0; n < 2; ++n) {
                sc[bj][n] = cscale ? *(const f32x4*)(cscale + col0 + bj * HALF + 4 * n) : (f32x4){1.f, 1.f, 1.f, 1.f};
                gn[bj][n] = gnext ? *(const f32x4*)(gnext + col0 + bj * HALF + 4 * n) : (f32x4){1.f, 1.f, 1.f, 1.f};
            }
#pragma unroll
        for (int ai = 0; ai < 2; ++ai)
#pragma unroll
            for (int m = 0; m < 4; ++m) {
                const int r = row0 + ai * HALF + m * 16; const size_t off = (size_t)r * ldc + col0; float s = 0.f;
#pragma unroll
                for (int bj = 0; bj < 2; ++bj) {
                    const f32x4 h0 = *(const f32x4*)(hin + off + bj * HALF), h1 = *(const f32x4*)(hin + off + bj * HALF + 4);
                    const f32x4 v0 = h0 + acc[ai][bj][m][0] * sc[bj][0], v1 = h1 + acc[ai][bj][m][1] * sc[bj][1];
                    *(f32x4*)(hout + off + bj * HALF) = v0; *(f32x4*)(hout + off + bj * HALF + 4) = v1;
                    s += (v0[0] * v0[0] + v0[1] * v0[1]) + (v0[2] * v0[2] + v0[3] * v0[3]) + (v1[0] * v1[0] + v1[1] * v1[1]) + (v1[2] * v1[2] + v1[3] * v1[3]);
                    if (xn) { const f32x4 a = v0 * gn[bj][0], b = v1 * gn[bj][1]; u32x4 w; w.x = cvt_pk_bf16(a[0], a[1]); w.y = cvt_pk_bf16(a[2], a[3]); w.z = cvt_pk_bf16(b[0], b[1]); w.w = cvt_pk_bf16(b[2], b[3]);
                        *(u32x4*)(xn + off + bj * HALF) = w; }
                }
                s += __shfl_xor(s, 16); s += __shfl_xor(s, 32);
                if (ss && fq == 0) unsafeAtomicAdd(ss + r, s);
                if (deep ? (m == 3) : (m & 1)) asm volatile("" ::: "memory");
            }
    }
};
struct EpiRelu2 {
    static constexpr bool PERM = true, AFTER_DRAIN = false;
    bf16_t* O; int ldc; const float* ss;
    __device__ __forceinline__ void pre(const Unit& u, int wr, int fr, float (&p)[8]) const { const int row0 = u.pm * BM + wr * 64 + fr;
        _Pragma("unroll") for (int i = 0; i < 8; ++i) p[i] = ld_agent(ss + row0 + (i >> 2) * HALF + (i & 3) * 16); }
    __device__ __forceinline__ void operator()(const f32x4 (&acc)[2][2][4][2], const Unit& u, int wr, int wc, int fr, int fq, const float (&p)[8]) const {
        const int row0 = u.pm * BM + wr * 64 + fr, col0 = u.pn * BM + wc * 32 + 8 * fq;
#pragma unroll
        for (int ai = 0; ai < 2; ++ai)
#pragma unroll
            for (int m = 0; m < 4; ++m) {
                const int r = row0 + ai * HALF + m * 16; const float rs = 1.0f / sqrtf(p[ai * 4 + m] * (1.0f / DM) + EPS);
                bf16_t* rowp = O + (size_t)r * ldc + col0;
#pragma unroll
                for (int bj = 0; bj < 2; ++bj) { f32x4 v0 = acc[ai][bj][m][0] * rs, v1 = acc[ai][bj][m][1] * rs;
#pragma unroll
                    for (int j = 0; j < 4; ++j) { const float a = fmaxf(v0[j], 0.f), b = fmaxf(v1[j], 0.f); v0[j] = a * a; v1[j] = b * b; }
                    u32x4 w; w.x = cvt_pk_bf16(v0[0], v0[1]); w.y = cvt_pk_bf16(v0[2], v0[3]); w.z = cvt_pk_bf16(v1[0], v1[1]); w.w = cvt_pk_bf16(v1[2], v1[3]);
                    *(u32x4*)(rowp + bj * HALF) = w; }
            }
    }
};
struct EpiRelu2Q {
    static constexpr bool PERM = true, AFTER_DRAIN = false;
    bf16_t* O; int ldc; const float* rsc; const float* csc; unsigned* amh;
    __device__ __forceinline__ void pre(const Unit& u, int wr, int fr, float (&p)[8]) const { const int row0 = u.pm * BM + wr * 64 + fr;
        _Pragma("unroll") for (int i = 0; i < 8; ++i) p[i] = rsc[row0 + (i >> 2) * HALF + (i & 3) * 16]; }
    __device__ __forceinline__ void operator()(const i32x4 (&acc)[2][2][4][2], const Unit& u, int wr, int wc, int fr, int fq, const float (&p)[8]) const {
        const int row0 = u.pm * BM + wr * 64 + fr, col0 = u.pn * BM + wc * 32 + 8 * fq;
        f32x4 cs[2][2];
#pragma unroll
        for (int bj = 0; bj < 2; ++bj)
#pragma unroll
            for (int n = 0; n < 2; ++n) cs[bj][n] = *(const f32x4*)(csc + col0 + bj * HALF + 4 * n);
#pragma unroll
        for (int ai = 0; ai < 2; ++ai)
#pragma unroll
            for (int m = 0; m < 4; ++m) {
                const int r = row0 + ai * HALF + m * 16; const float rs = p[ai * 4 + m]; float mxr = 0.f;
                bf16_t* rowp = O + (size_t)r * ldc + col0;
#pragma unroll
                for (int bj = 0; bj < 2; ++bj) { f32x4 v0 = __builtin_convertvector(acc[ai][bj][m][0], f32x4) * (cs[bj][0] * rs), v1 = __builtin_convertvector(acc[ai][bj][m][1], f32x4) * (cs[bj][1] * rs);
#pragma unroll
                    for (int j = 0; j < 4; ++j) { const float a = fmaxf(v0[j], 0.f), b = fmaxf(v1[j], 0.f); v0[j] = a * a; v1[j] = b * b; mxr = fmaxf(mxr, fmaxf(v0[j], v1[j])); }
                    u32x4 w; w.x = cvt_pk_bf16(v0[0], v0[1]); w.y = cvt_pk_bf16(v0[2], v0[3]); w.z = cvt_pk_bf16(v1[0], v1[1]); w.w = cvt_pk_bf16(v1[2], v1[3]);
                    *(u32x4*)(rowp + bj * HALF) = w; }
                if (amh) { mxr = fmaxf(mxr, __shfl_xor(mxr, 16)); mxr = fmaxf(mxr, __shfl_xor(mxr, 32));
                    if (fq == 0) (void)__hip_atomic_fetch_max(amh + r, __builtin_bit_cast(unsigned, mxr), __ATOMIC_RELAXED, __HIP_MEMORY_SCOPE_AGENT); }
            }
    }
};
struct EpiInProj {
    static constexpr bool PERM = true, AFTER_DRAIN = false;
    bf16_t *Q, *K, *V, *G; float* R; const float* ss;
    __device__ __forceinline__ void pre(const Unit& u, int wr, int fr, float (&p)[8]) const { const int row0 = u.pm * BM + wr * 64 + fr;
        _Pragma("unroll") for (int i = 0; i < 8; ++i) p[i] = ld_agent(ss + row0 + (i >> 2) * HALF + (i & 3) * 16); }
    __device__ __forceinline__ void operator()(const f32x4 (&acc)[2][2][4][2], const Unit& u, int wr, int wc, int fr, int fq, const float (&p)[8]) const {
        const int row0 = u.pm * BM + wr * 64 + fr; const int pn = u.pn;
        bf16_t* base; int ldc, colt;
        if (pn < 8) { base = Q; ldc = KD; colt = pn * BM; } else if (pn < 16) { base = K; ldc = KD; colt = (pn - 8) * BM; }
        else if (pn < 32) { base = V; ldc = VD; colt = (pn - 16) * BM; } else { base = G; ldc = VD; colt = (pn - 32) * BM; }
        const int col0 = colt + wc * 32 + 8 * fq;
#pragma unroll
        for (int ai = 0; ai < 2; ++ai)
#pragma unroll
            for (int m = 0; m < 4; ++m) {
                const int r = row0 + ai * HALF + m * 16; const float rs = 1.0f / sqrtf(p[ai * 4 + m] * (1.0f / DM) + EPS);
                if (pn < 48) {
                    bf16_t* rowp = base + (size_t)r * ldc + col0;
#pragma unroll
                    for (int bj = 0; bj < 2; ++bj) { const f32x4 v0 = acc[ai][bj][m][0] * rs, v1 = acc[ai][bj][m][1] * rs;
                        u32x4 w; w.x = cvt_pk_bf16(v0[0], v0[1]); w.y = cvt_pk_bf16(v0[2], v0[3]); w.z = cvt_pk_bf16(v1[0], v1[1]); w.w = cvt_pk_bf16(v1[2], v1[3]);
                        *(u32x4*)(rowp + bj * HALF) = w; }
                } else if (wc == 0) {
                    float* rp = R + (size_t)r * 32 + 8 * fq;
                    *(f32x4*)rp = acc[ai][0][m][0] * rs; *(f32x4*)(rp + 4) = acc[ai][0][m][1] * rs;
                }
            }
    }
};

struct EpiInProjQ {
    static constexpr bool PERM = true, AFTER_DRAIN = false;
    bf16_t *Q, *K, *V, *G; float* R; const float* rsc; const float* csc;
    __device__ __forceinline__ void pre(const Unit& u, int wr, int fr, float (&p)[8]) const { const int row0 = u.pm * BM + wr * 64 + fr;
        _Pragma("unroll") for (int i = 0; i < 8; ++i) p[i] = rsc[row0 + (i >> 2) * HALF + (i & 3) * 16]; }
    __device__ __forceinline__ void operator()(const i32x4 (&acc)[2][2][4][2], const Unit& u, int wr, int wc, int fr, int fq, const float (&p)[8]) const {
        const int row0 = u.pm * BM + wr * 64 + fr; const int pn = u.pn;
        bf16_t* base; int ldc, colt;
        if (pn < 8) { base = Q; ldc = KD; colt = pn * BM; } else if (pn < 16) { base = K; ldc = KD; colt = (pn - 8) * BM; }
        else if (pn < 32) { base = V; ldc = VD; colt = (pn - 16) * BM; } else { base = G; ldc = VD; colt = (pn - 32) * BM; }
        const int col0 = colt + wc * 32 + 8 * fq, ccol = pn * BM + wc * 32 + 8 * fq;
        f32x4 cs[2][2];
#pragma unroll
        for (int bj = 0; bj < 2; ++bj)
#pragma unroll
            for (int n = 0; n < 2; ++n) cs[bj][n] = *(const f32x4*)(csc + ccol + bj * HALF + 4 * n);
#pragma unroll
        for (int ai = 0; ai < 2; ++ai)
#pragma unroll
            for (int m = 0; m < 4; ++m) {
                const int r = row0 + ai * HALF + m * 16; const float rs = p[ai * 4 + m];
                if (pn < 48) {
                    bf16_t* rowp = base + (size_t)r * ldc + col0;
#pragma unroll
                    for (int bj = 0; bj < 2; ++bj) { const f32x4 v0 = __builtin_convertvector(acc[ai][bj][m][0], f32x4) * (cs[bj][0] * rs), v1 = __builtin_convertvector(acc[ai][bj][m][1], f32x4) * (cs[bj][1] * rs);
                        u32x4 w; w.x = cvt_pk_bf16(v0[0], v0[1]); w.y = cvt_pk_bf16(v0[2], v0[3]); w.z = cvt_pk_bf16(v1[0], v1[1]); w.w = cvt_pk_bf16(v1[2], v1[3]);
                        *(u32x4*)(rowp + bj * HALF) = w; }
                } else if (wc == 0) {
                    float* rp = R + (size_t)r * 32 + 8 * fq;
                    *(f32x4*)rp = __builtin_convertvector(acc[ai][0][m][0], f32x4) * (cs[0][0] * rs); *(f32x4*)(rp + 4) = __builtin_convertvector(acc[ai][0][m][1], f32x4) * (cs[0][1] * rs);
                }
            }
    }
};

template <bool I8> struct AccT { typedef f32x4 t; };
template <> struct AccT<true> { typedef i32x4 t; };
template <class Epi, class Sched, bool ALIGN_EPI = true, bool I8 = false>
__device__ __forceinline__ void gemm_phase(PG8_LAS unsigned char* lds, const Gemm g, const Sched& S, const Epi& E) {
    const int tid = threadIdx.x, wid = __builtin_amdgcn_readfirstlane(tid >> 6), lane = tid & 63, wr = wid >> 2, wc = wid & 3, fr = lane & 15, fq = lane >> 4;
    const int K = g.K, nt = K / BK, lda = g.lda;
    unsigned voffA[2], voffB[2];
#pragma unroll
    for (int i = 0; i < 2; ++i) { int R, C; stage_rc(tid * 16 + i * 8192, R, C); const int Rb = Epi::PERM ? ((R & ~31) + perm32(R & 31)) : R;
        voffA[i] = (unsigned)(R * lda + C) * 2u; voffB[i] = (unsigned)(Rb * K + C) * 2u; }
    const size_t kstep = (size_t)(BK * 2);
    const size_t hstepA = (size_t)HALF * lda * 2, hstepB = (size_t)HALF * K * 2;
    const size_t tstepA = 2 * hstepA, tstepB = 2 * hstepB;
    const unsigned ldsw = (unsigned)wid * 1024u;
    const unsigned ldsbase = (unsigned)(uintptr_t)lds;
    const int aoff = lds_byte(wr * 64 + fr, fq * 8), boff = lds_byte(wc * 32 + fr, fq * 8);
#define PG8_SA(b, h) (((b) * 2 + (h)) * HTB)
#define PG8_SB(b, h) ((4 + (b) * 2 + (h)) * HTB)
#define PG8_STAGE(bufoff, gbase, voff) do { _Pragma("unroll") for (int _i = 0; _i < 2; ++_i) { unsigned _keep; \
        asm volatile("s_mov_b32 %0, m0\n\ts_mov_b32 m0, %3\n\ts_nop 0\n\tglobal_load_lds_dwordx4 %1, %2\n\ts_mov_b32 m0, %0" \
            : "=&s"(_keep) : "v"((voff)[_i]), "s"((const char*)(gbase)), "s"(ldsbase + (unsigned)(bufoff) + ldsw + (unsigned)(_i * 8192)) : "memory"); } } while (0)
#define PG8_LDA(dst, b, h) do { _Pragma("unroll") for (int m = 0; m < 4; ++m) _Pragma("unroll") for (int k = 0; k < 2; ++k) dst[m][k] = *(const PG8_LAS bf16x8*)(lds + PG8_SA(b, h) + aoff + m * 2048 + k * 1024); } while (0)
#define PG8_LDB(dst, b, h) do { _Pragma("unroll") for (int n = 0; n < 2; ++n) _Pragma("unroll") for (int k = 0; k < 2; ++k) dst[n][k] = *(const PG8_LAS bf16x8*)(lds + PG8_SB(b, h) + boff + n * 2048 + k * 1024); } while (0)
#define PG8_MMA(ai, bj, At, Bt) do { _Pragma("unroll") for (int m = 0; m < 4; ++m) _Pragma("unroll") for (int n = 0; n < 2; ++n) _Pragma("unroll") for (int k = 0; k < 2; ++k) \
        { if constexpr (I8) acc[ai][bj][m][n] = __builtin_amdgcn_mfma_i32_16x16x64_i8(__builtin_bit_cast(i32x4, Bt[n][k]), __builtin_bit_cast(i32x4, At[m][k]), acc[ai][bj][m][n], 0, 0, 0); \
          else acc[ai][bj][m][n] = __builtin_amdgcn_mfma_f32_16x16x32_bf16(Bt[n][k], At[m][k], acc[ai][bj][m][n], 0, 0, 0); } } while (0)
#define PG8_PRIO(p) __builtin_amdgcn_s_setprio(p)
#define PG8_WAIT_V(n) asm volatile("s_waitcnt vmcnt(" #n ")" ::: "memory")
#define PG8_WAIT_L(n) asm volatile("s_waitcnt lgkmcnt(" #n ")" ::: "memory")
#define PG8_BAR __builtin_amdgcn_s_barrier()
#define PG8_SCHED __builtin_amdgcn_sched_barrier(0)
#define PG8_AOFF(u) ((size_t)(u).pm * tstepA + (g.grp ? (size_t)((u).pn / g.grp) * (size_t)K * 2 : (size_t)0))
    Unit cur, nxt; int ui = 0;
    if (!S.next(0, cur)) return;
    typedef typename AccT<I8>::t acc_t;
    acc_t acc[2][2][4][2];
#pragma unroll
    for (int a = 0; a < 2; ++a)
#pragma unroll
        for (int b = 0; b < 2; ++b)
#pragma unroll
            for (int m = 0; m < 4; ++m)
#pragma unroll
                for (int n = 0; n < 2; ++n) acc[a][b][m][n] = (acc_t)(0);
    bf16x8 At[4][2], B0[2][2], B1[2][2];
    const char* cA = (const char*)g.A + PG8_AOFF(cur); const char* cB = (const char*)g.Bt + (size_t)cur.pn * tstepB;
    S.a_ready(cur);
    float pre[8]; E.pre(cur, wr, fr, pre);
    PG8_STAGE(PG8_SB(0, 0), cB, voffB); PG8_STAGE(PG8_SB(0, 1), cB + hstepB, voffB); PG8_STAGE(PG8_SA(0, 0), cA, voffA); PG8_STAGE(PG8_SA(0, 1), cA + hstepA, voffA);
    if (wr == 1) PG8_BAR;
    PG8_WAIT_V(2); PG8_BAR;
    PG8_STAGE(PG8_SB(1, 0), cB + kstep, voffB); PG8_STAGE(PG8_SA(1, 0), cA + kstep, voffA); PG8_STAGE(PG8_SB(1, 1), cB + hstepB + kstep, voffB);
    PG8_WAIT_V(6); PG8_BAR;
    for (;;) {
        const bool has_next = S.next(ui + 1, nxt);
        const char* nA = has_next ? (const char*)g.A + PG8_AOFF(nxt) : cA; const char* nB = has_next ? (const char*)g.Bt + (size_t)nxt.pn * tstepB : cB;
        for (int t = 0; t < nt; t += 2) {
            const bool last = (t == nt - 2);
            const char* a1 = cA + (size_t)(t + 1) * kstep;
            const char* a2 = last ? nA : cA + (size_t)(t + 2) * kstep; const char* b2 = last ? nB : cB + (size_t)(t + 2) * kstep;
            const char* a3 = a2 + kstep; const char* b3 = b2 + kstep;
            if (last && has_next) S.a_ready(nxt);
            PG8_LDB(B0, 0, 0); PG8_LDB(B1, 0, 1); PG8_SCHED; PG8_LDA(At, 0, 0); PG8_STAGE(PG8_SA(1, 1), a1 + hstepA, voffA);
            PG8_WAIT_V(8); PG8_WAIT_L(0); PG8_PRIO(1); PG8_BAR; PG8_MMA(0, 0, At, B0); PG8_MMA(0, 1, At, B1); PG8_PRIO(0); PG8_BAR; PG8_SCHED;
            PG8_LDA(At, 0, 1); PG8_STAGE(PG8_SB(0, 0), b2, voffB); PG8_STAGE(PG8_SB(0, 1), b2 + hstepB, voffB); PG8_STAGE(PG8_SA(0, 0), a2, voffA);
            PG8_WAIT_V(8); PG8_WAIT_L(0); PG8_PRIO(1); PG8_BAR; PG8_MMA(1, 0, At, B0); PG8_MMA(1, 1, At, B1); PG8_PRIO(0); PG8_BAR; PG8_SCHED;
            PG8_LDB(B0, 1, 0); PG8_LDB(B1, 1, 1); PG8_SCHED; PG8_LDA(At, 1, 0); PG8_STAGE(PG8_SA(0, 1), a2 + hstepA, voffA);
            PG8_WAIT_V(8); PG8_WAIT_L(0); PG8_PRIO(1); PG8_BAR; PG8_MMA(0, 0, At, B0); PG8_MMA(0, 1, At, B1); PG8_PRIO(0); PG8_BAR; PG8_SCHED;
            PG8_LDA(At, 1, 1); PG8_STAGE(PG8_SB(1, 0), b3, voffB); PG8_STAGE(PG8_SB(1, 1), b3 + hstepB, voffB); PG8_STAGE(PG8_SA(1, 0), a3, voffA);
            PG8_WAIT_V(8); PG8_WAIT_L(0); PG8_PRIO(1); PG8_BAR; PG8_MMA(1, 0, At, B0); PG8_MMA(1, 1, At, B1); PG8_PRIO(0); PG8_BAR; PG8_SCHED;
        }
        if constexpr (ALIGN_EPI) { if (wr == 0) PG8_BAR; }
        E(acc, cur, wr, wc, fr, fq, pre); S.done(cur);
        if (!has_next) break;
#pragma unroll
        for (int a = 0; a < 2; ++a)
#pragma unroll
            for (int b = 0; b < 2; ++b)
#pragma unroll
                for (int m = 0; m < 4; ++m)
#pragma unroll
                    for (int n = 0; n < 2; ++n) acc[a][b][m][n] = (acc_t)(0);
        cur = nxt; cA = nA; cB = nB; ++ui;
        E.pre(cur, wr, fr, pre);
        if constexpr (ALIGN_EPI) { if (wr == 1) PG8_BAR; }
    }
    PG8_WAIT_V(0);
    if constexpr (!ALIGN_EPI) { if (wr == 0) PG8_BAR; }
    PG8_BAR;
#undef PG8_SA
#undef PG8_SB
#undef PG8_STAGE
#undef PG8_LDA
#undef PG8_LDB
#undef PG8_MMA
#undef PG8_PRIO
#undef PG8_WAIT_V
#undef PG8_WAIT_L
#undef PG8_BAR
#undef PG8_SCHED
#undef PG8_AOFF
}
}

#define XB_TMO      128
#define XB_XCNT(j)  (256  + 64 * (j))
#define XB_XSUB(j)  (1280 + 64 * (j))
#define XB_XGEN(j)  (2304 + 64 * (j))
#define XB_TOP      3328
#define XB_TOPGEN   3392
#define XCD_BAR_WORDS 3456
#define XB_SPIN_CAP (1u << 18)

__device__ __forceinline__ unsigned xb_ld(unsigned* p)              { return __hip_atomic_load(p, __ATOMIC_RELAXED, __HIP_MEMORY_SCOPE_AGENT); }
__device__ __forceinline__ unsigned xb_add(unsigned* p, unsigned v) { return __hip_atomic_fetch_add(p, v, __ATOMIC_RELAXED, __HIP_MEMORY_SCOPE_AGENT); }
__device__ __forceinline__ unsigned xb_xcc_id() { return (unsigned)__builtin_amdgcn_s_getreg((3 << 11) | 20) & 0xFu; }
#define XB_SPIN(cond, bar) do { unsigned _sp = 0; while (cond) { __builtin_amdgcn_s_sleep(1); \
    if ((++_sp & 255u) == 0u) { if (xb_ld(&(bar)[XB_TMO])) break; if (_sp > XB_SPIN_CAP) { atomicAdd(&(bar)[XB_TMO], 1u); break; } } } } while (0)

struct XcdBarrier { unsigned* bar; unsigned x; volatile LAS unsigned* st; };

__device__ __forceinline__ XcdBarrier xcd_barrier_post(unsigned* bar, volatile LAS unsigned* st) {
    XcdBarrier b; b.bar = bar; b.x = xb_xcc_id(); b.st = st;
    if (threadIdx.x == 0) (void)xb_add(&bar[XB_XCNT(b.x)], 1u);
    return b;
}
__device__ __forceinline__ void xcd_barrier_complete(unsigned* bar, unsigned x, unsigned& nloc, unsigned& nx) {
    const unsigned G = gridDim.x * gridDim.y * gridDim.z;
    unsigned sum, cnt, mine, sp = 0u;
    for (;;) {
        sum = 0u; cnt = 0u; mine = 0u;
#pragma unroll
        for (unsigned j = 0; j < 16; ++j) { const unsigned c = xb_ld(&bar[XB_XCNT(j)]); sum += c; cnt += (c > 0u) ? 1u : 0u; mine = (j == x) ? c : mine; }
        if (sum == G) break;
        __builtin_amdgcn_s_sleep(1);
        if ((++sp & 255u) == 0u) { if (xb_ld(&bar[XB_TMO])) break; if (sp > XB_SPIN_CAP) { atomicAdd(&bar[XB_TMO], 1u); break; } }
    }
    nloc = mine > 0u ? mine : 1u; nx = cnt > 0u ? cnt : 1u;
}
__device__ __forceinline__ void xcd_barrier(const XcdBarrier& b) {
    asm volatile("s_waitcnt vmcnt(0)" ::: "memory");
    __syncthreads();
    if (threadIdx.x == 0) {
        unsigned* bar = b.bar;
        __builtin_amdgcn_s_waitcnt(0);
        unsigned nloc = b.st[0], nx = b.st[1];
        if (nloc == 0u) { xcd_barrier_complete(bar, b.x, nloc, nx); b.st[0] = nloc; b.st[1] = nx; }
        const unsigned old = xb_add(&bar[XB_XSUB(b.x)], 1u);
        const unsigned gen = old / nloc;
        if (old + 1u == (gen + 1u) * nloc) {
            __builtin_amdgcn_fence(__ATOMIC_RELEASE, "agent");
            asm volatile("s_waitcnt vmcnt(0)" ::: "memory");
            const unsigned og = xb_add(&bar[XB_TOP], 1u);
            const unsigned tg = og / nx;
            if (og + 1u == (tg + 1u) * nx) xb_add(&bar[XB_TOPGEN], 1u);
            else XB_SPIN(xb_ld(&bar[XB_TOPGEN]) == tg, bar);
            __builtin_amdgcn_fence(__ATOMIC_ACQUIRE, "agent");
            xb_add(&bar[XB_XGEN(b.x)], 1u);
            asm volatile("s_waitcnt vmcnt(0)" ::: "memory");
        } else {
            XB_SPIN(xb_ld(&bar[XB_XGEN(b.x)]) == gen, bar);
            __builtin_amdgcn_fence(__ATOMIC_ACQUIRE, "agent");
            asm volatile("s_waitcnt vmcnt(0)" ::: "memory");
        }
    }
    __syncthreads();
}

struct Args { const float* in[15]; float* out; unsigned char* ws; int ph_lo, ph_hi; };
struct Frame {
    LAS unsigned char* lds;
    int tid, lane, wave, vcu, G;
};
__device__ __forceinline__ float wave_sum(float v) {
#pragma unroll
    for (int o = 1; o < 64; o <<= 1) v += __shfl_xor(v, o);
    return v;
}
__device__ __forceinline__ void p0_transpose_item(const float* W, int K, int N, bf16* WT, LAS float* scr, int item, int lane) {
    const int nblk = (N + 63) / 64, kb = item / nblk, nb = item % nblk, k0 = 64 * kb, n0 = 64 * nb;
    const int nn = 4 * (lane & 15);
    f32x4 v[16];
#pragma unroll
    for (int i = 0; i < 16; ++i) { const int kk = 4 * i + (lane >> 4); v[i] = (n0 + nn < N) ? *(const GAS f32x4*)(W + (size_t)(k0 + kk) * N + n0 + nn) : (f32x4){0.f, 0.f, 0.f, 0.f}; }
#pragma unroll
    for (int i = 0; i < 16; ++i) { const int kk = 4 * i + (lane >> 4); LAS float* d = scr + kk * 65 + nn; d[0] = v[i].x; d[1] = v[i].y; d[2] = v[i].z; d[3] = v[i].w; }
    LDS_WAIT(); asm volatile("" ::: "memory");
    const int c = lane & 7;
#pragma unroll
    for (int j = 0; j < 8; ++j) { const int n = (lane >> 3) + 8 * j; const LAS float* s = scr + (8 * c) * 65 + n;
        v4u o; o.x = pk2(s[0 * 65], s[1 * 65]); o.y = pk2(s[2 * 65], s[3 * 65]); o.z = pk2(s[4 * 65], s[5 * 65]); o.w = pk2(s[6 * 65], s[7 * 65]);
        if (n0 + n < N) *(GAS v4u*)(WT + (size_t)(n0 + n) * K + k0 + 8 * c) = o; }
    LDS_WAIT(); asm volatile("" ::: "memory");
}
constexpr int P0_SCR = 64 * 65 * 4;

__device__ __forceinline__ float wave_max(float v) {
#pragma unroll
    for (int o = 1; o < 64; o <<= 1) v = fmaxf(v, __shfl_xor(v, o));
    return v;
}
__device__ __forceinline__ unsigned q8(float v) { return (unsigned)(int)__builtin_rintf(v) & 0xffu; }
__device__ __forceinline__ void convert_strip_i8(Frame& F, const float* W, int N, unsigned char* WT, float* colscale, int strip, int KT = 8) {
    LAS float* scr = (LAS float*)(F.lds + F.wave * P0_SCR);
    LAS float* part = (LAS float*)(F.lds + 8 * P0_SCR);
    const int n0 = 64 * strip, nn = 4 * (F.lane & 15), lane = F.lane;
    const bool okc = n0 + nn < N;
    f32x4 am = {0.f, 0.f, 0.f, 0.f};
    for (int t = 0; t < KT; ++t) {
        const int k0 = 64 * (KT * F.wave + t);
        f32x4 v[16];
#pragma unroll
        for (int i = 0; i < 16; ++i) { const int kk = 4 * i + (lane >> 4); v[i] = okc ? *(const GAS f32x4*)(W + (size_t)(k0 + kk) * N + n0 + nn) : (f32x4){0.f, 0.f, 0.f, 0.f}; }
#pragma unroll
        for (int i = 0; i < 16; ++i) { am.x = fmaxf(am.x, fabsf(v[i].x)); am.y = fmaxf(am.y, fabsf(v[i].y)); am.z = fmaxf(am.z, fabsf(v[i].z)); am.w = fmaxf(am.w, fabsf(v[i].w)); }
    }
#pragma unroll
    for (int o = 16; o < 64; o <<= 1) { am.x = fmaxf(am.x, __shfl_xor(am.x, o)); am.y = fmaxf(am.y, __shfl_xor(am.y, o)); am.z = fmaxf(am.z, __shfl_xor(am.z, o)); am.w = fmaxf(am.w, __shfl_xor(am.w, o)); }
    if (lane < 16) *(LAS f32x4*)(part + F.wave * 64 + nn) = am;
    __syncthreads();
    f32x4 cm = {0.f, 0.f, 0.f, 0.f};
#pragma unroll
    for (int w = 0; w < 8; ++w) { const f32x4 p = *(const LAS f32x4*)(part + w * 64 + nn); cm.x = fmaxf(cm.x, p.x); cm.y = fmaxf(cm.y, p.y); cm.z = fmaxf(cm.z, p.z); cm.w = fmaxf(cm.w, p.w); }
    if (F.wave == 0 && lane < 16 && okc) *(f32x4*)(colscale + n0 + nn) = cm * (1.0f / 127.0f);
    f32x4 inv; inv.x = cm.x > 0.f ? 127.0f / cm.x : 0.f; inv.y = cm.y > 0.f ? 127.0f / cm.y : 0.f; inv.z = cm.z > 0.f ? 127.0f / cm.z : 0.f; inv.w = cm.w > 0.f ? 127.0f / cm.w : 0.f;
    const int c = lane & 7;
    for (int t = 0; t < KT; ++t) {
        const int k0 = 64 * (KT * F.wave + t);
        f32x4 v[16];
#pragma unroll
        for (int i = 0; i < 16; ++i) { const int kk = 4 * i + (lane >> 4); v[i] = okc ? *(const GAS f32x4*)(W + (size_t)(k0 + kk) * N + n0 + nn) : (f32x4){0.f, 0.f, 0.f, 0.f}; }
#pragma unroll
        for (int i = 0; i < 16; ++i) { const int kk = 4 * i + (lane >> 4); LAS float* d = scr + kk * 65 + nn; const f32x4 q = v[i] * inv; d[0] = q.x; d[1] = q.y; d[2] = q.z; d[3] = q.w; }
        LDS_WAIT(); asm volatile("" ::: "memory");
#pragma unroll
        for (int j = 0; j < 8; ++j) { const int n = (lane >> 3) + 8 * j; const LAS float* sp = scr + (8 * c) * 65 + n;
            v2u o; o.x = q8(sp[0 * 65]) | (q8(sp[1 * 65]) << 8) | (q8(sp[2 * 65]) << 16) | (q8(sp[3 * 65]) << 24);
            o.y = q8(sp[4 * 65]) | (q8(sp[5 * 65]) << 8) | (q8(sp[6 * 65]) << 16) | (q8(sp[7 * 65]) << 24);
            if (n0 + n < N) *(GAS v2u*)(WT + (size_t)(n0 + n) * (512 * KT) + k0 + 8 * c) = o; }
        LDS_WAIT(); asm volatile("" ::: "memory");
    }
    __syncthreads();
}
__device__ __forceinline__ void convert_strip32_i8(Frame& F, const float* W, int N, unsigned char* WT, float* colscale, int strip, int KT) {
    LAS float* scr = (LAS float*)(F.lds + F.wave * P0_SCR);
    LAS float* part = (LAS float*)(F.lds + 8 * P0_SCR);
    const int lane = F.lane, n0 = 32 * strip, nn = 4 * (lane & 7), kr = lane >> 3;
    f32x4 am = {0.f, 0.f, 0.f, 0.f};
    for (int t = 0; t < KT; ++t) {
        const int k0 = 64 * (KT * F.wave + t);
        f32x4 v[8];
#pragma unroll
        for (int i = 0; i < 8; ++i) v[i] = *(const GAS f32x4*)(W + (size_t)(k0 + 8 * i + kr) * N + n0 + nn);
#pragma unroll
        for (int i = 0; i < 8; ++i) { am.x = fmaxf(am.x, fabsf(v[i].x)); am.y = fmaxf(am.y, fabsf(v[i].y)); am.z = fmaxf(am.z, fabsf(v[i].z)); am.w = fmaxf(am.w, fabsf(v[i].w)); }
    }
#pragma unroll
    for (int o = 8; o < 64; o <<= 1) { am.x = fmaxf(am.x, __shfl_xor(am.x, o)); am.y = fmaxf(am.y, __shfl_xor(am.y, o)); am.z = fmaxf(am.z, __shfl_xor(am.z, o)); am.w = fmaxf(am.w, __shfl_xor(am.w, o)); }
    if (lane < 8) *(LAS f32x4*)(part + F.wave * 32 + nn) = am;
    __syncthreads();
    f32x4 cm = {0.f, 0.f, 0.f, 0.f};
#pragma unroll
    for (int w = 0; w < 8; ++w) { const f32x4 p = *(const LAS f32x4*)(part + w * 32 + nn); cm.x = fmaxf(cm.x, p.x); cm.y = fmaxf(cm.y, p.y); cm.z = fmaxf(cm.z, p.z); cm.w = fmaxf(cm.w, p.w); }
    if (F.wave == 0 && lane < 8) *(f32x4*)(colscale + n0 + nn) = cm * (1.0f / 127.0f);
    f32x4 inv; inv.x = cm.x > 0.f ? 127.0f / cm.x : 0.f; inv.y = cm.y > 0.f ? 127.0f / cm.y : 0.f; inv.z = cm.z > 0.f ? 127.0f / cm.z : 0.f; inv.w = cm.w > 0.f ? 127.0f / cm.w : 0.f;
    const int c = lane & 7;
    for (int t = 0; t < KT; ++t) {
        const int k0 = 64 * (KT * F.wave + t);
        f32x4 v[8];
#pragma unroll
        for (int i = 0; i < 8; ++i) v[i] = *(const GAS f32x4*)(W + (size_t)(k0 + 8 * i + kr) * N + n0 + nn);
#pragma unroll
        for (int i = 0; i < 8; ++i) { LAS float* d = scr + (8 * i + kr) * 33 + nn; const f32x4 q = v[i] * inv; d[0] = q.x; d[1] = q.y; d[2] = q.z; d[3] = q.w; }
        LDS_WAIT(); asm volatile("" ::: "memory");
#pragma unroll
        for (int j = 0; j < 4; ++j) { const int n = (lane >> 3) + 8 * j; const LAS float* sp = scr + (8 * c) * 33 + n;
            v2u o; o.x = q8(sp[0 * 33]) | (q8(sp[1 * 33]) << 8) | (q8(sp[2 * 33]) << 16) | (q8(sp[3 * 33]) << 24);
            o.y = q8(sp[4 * 33]) | (q8(sp[5 * 33]) << 8) | (q8(sp[6 * 33]) << 16) | (q8(sp[7 * 33]) << 24);
            *(GAS v2u*)(WT + (size_t)(n0 + n) * (512 * KT) + k0 + 8 * c) = o; }
        LDS_WAIT(); asm volatile("" ::: "memory");
    }
    __syncthreads();
}
__device__ __forceinline__ void phase_quant(Frame& F, const float* H, const float* g, unsigned char* XQ, float* rowscale) {
    const int gw = F.vcu * 8 + F.wave, NGW = F.G * 8;
    f32x4 gv[16];
#pragma unroll
    for (int j = 0; j < 16; ++j) gv[j] = *((const f32x4*)g + F.lane + 64 * j);
    for (int m = gw; m < M; m += NGW) {
        const GAS f32x4* hr = (const GAS f32x4*)(H + (size_t)m * DM) + F.lane;
        f32x4 v[16]; float s = 0.f, mx = 0.f;
#pragma unroll
        for (int j = 0; j < 16; ++j) v[j] = hr[64 * j];
#pragma unroll
        for (int j = 0; j < 16; ++j) { s += (v[j].x * v[j].x + v[j].y * v[j].y) + (v[j].z * v[j].z + v[j].w * v[j].w); v[j] = v[j] * gv[j];
            mx = fmaxf(fmaxf(mx, fmaxf(fabsf(v[j].x), fabsf(v[j].y))), fmaxf(fabsf(v[j].z), fabsf(v[j].w))); }
        s = wave_sum(s); mx = wave_max(mx);
        const float inv = mx > 0.f ? 127.0f / mx : 0.f;
        GAS unsigned* dst = (GAS unsigned*)(XQ + (size_t)m * DM) + F.lane;
#pragma unroll
        for (int j = 0; j < 16; ++j) dst[64 * j] = q8(v[j].x * inv) | (q8(v[j].y * inv) << 8) | (q8(v[j].z * inv) << 16) | (q8(v[j].w * inv) << 24);
        if (F.lane == 0) rowscale[m] = mx * (1.0f / 127.0f) / sqrtf(s * (1.0f / DM) + EPS);
    }
}

__device__ __forceinline__ void cas_umax_agent(unsigned* p, unsigned v) {
    unsigned old = __hip_atomic_load(p, __ATOMIC_RELAXED, __HIP_MEMORY_SCOPE_AGENT);
    while (old < v && !__hip_atomic_compare_exchange_strong(p, &old, v, __ATOMIC_RELAXED, __ATOMIC_RELAXED, __HIP_MEMORY_SCOPE_AGENT)) {}
}
__device__ __forceinline__ void w2_absmax_sweep(Frame& F, const float* W, float* part) {
    for (int sl = F.vcu; sl < FF / 64; sl += F.G) {
        const float* base = W + (size_t)sl * 64 * DM + F.tid * 8;
        f32x4 m0 = {0.f, 0.f, 0.f, 0.f}, m1 = {0.f, 0.f, 0.f, 0.f};
        for (int r0 = 0; r0 < 64; r0 += 8) {
            f32x4 a[8], b[8];
#pragma unroll
            for (int k = 0; k < 8; ++k) { a[k] = *(const GAS f32x4*)(base + (size_t)(r0 + k) * DM); b[k] = *(const GAS f32x4*)(base + (size_t)(r0 + k) * DM + 4); }
#pragma unroll
            for (int k = 0; k < 8; ++k) { m0.x = fmaxf(m0.x, fabsf(a[k].x)); m0.y = fmaxf(m0.y, fabsf(a[k].y)); m0.z = fmaxf(m0.z, fabsf(a[k].z)); m0.w = fmaxf(m0.w, fabsf(a[k].w));
                                          m1.x = fmaxf(m1.x, fabsf(b[k].x)); m1.y = fmaxf(m1.y, fabsf(b[k].y)); m1.z = fmaxf(m1.z, fabsf(b[k].z)); m1.w = fmaxf(m1.w, fabsf(b[k].w)); }
        }
        float* c = part + (size_t)sl * DM + F.tid * 8;
        *(f32x4*)c = m0; *(f32x4*)(c + 4) = m1;
    }
}
__device__ __forceinline__ void p0_transpose_item_i8(const float* W, int K, int N, unsigned char* WT, const unsigned* cmax, int* csum, LAS float* scr, int item, int lane) {
    const int nblk = N / 64, kb = item / nblk, nb = item % nblk, k0 = 64 * kb, n0 = 64 * nb;
    const int nn = 4 * (lane & 15);
    f32x4 inv; { const v4u cb = *(const v4u*)(cmax + n0 + nn);
        const float c0 = __builtin_bit_cast(float, cb.x), c1 = __builtin_bit_cast(float, cb.y), c2 = __builtin_bit_cast(float, cb.z), c3 = __builtin_bit_cast(float, cb.w);
        inv.x = c0 > 0.f ? 127.0f / c0 : 0.f; inv.y = c1 > 0.f ? 127.0f / c1 : 0.f; inv.z = c2 > 0.f ? 127.0f / c2 : 0.f; inv.w = c3 > 0.f ? 127.0f / c3 : 0.f; }
    f32x4 v[16];
#pragma unroll
    for (int i = 0; i < 16; ++i) { const int kk = 4 * i + (lane >> 4); v[i] = *(const GAS f32x4*)(W + (size_t)(k0 + kk) * N + n0 + nn); }
#pragma unroll
    for (int i = 0; i < 16; ++i) { const int kk = 4 * i + (lane >> 4); LAS float* d = scr + kk * 65 + nn; const f32x4 q = v[i] * inv; d[0] = q.x; d[1] = q.y; d[2] = q.z; d[3] = q.w; }
    LDS_WAIT(); asm volatile("" ::: "memory");
    const int c = lane & 7;
#pragma unroll
    for (int j = 0; j < 8; ++j) { const int n = (lane >> 3) + 8 * j; const LAS float* sp = scr + (8 * c) * 65 + n;
        int q[8];
#pragma unroll
        for (int e = 0; e < 8; ++e) q[e] = (int)__builtin_rintf(sp[e * 65]);
        v2u o; o.x = (unsigned)(q[0] & 255) | ((unsigned)(q[1] & 255) << 8) | ((unsigned)(q[2] & 255) << 16) | ((unsigned)q[3] << 24);
        o.y = (unsigned)(q[4] & 255) | ((unsigned)(q[5] & 255) << 8) | ((unsigned)(q[6] & 255) << 16) | ((unsigned)q[7] << 24);
        *(GAS v2u*)(WT + (size_t)(n0 + n) * K + k0 + 8 * c) = o;
        (void)csum; }
    LDS_WAIT(); asm volatile("" ::: "memory");
}
__device__ __forceinline__ void phase_quant_hid(Frame& F, const bf16* HIDp, const unsigned* amh, unsigned char* HQ, float* rowscale) {
    const int gw = F.vcu * 8 + F.wave, NGW = F.G * 8;
    for (int m = gw; m < M; m += NGW) {
        const GAS v4u* src = (const GAS v4u*)(HIDp + (size_t)m * FF) + F.lane;
        const float amax = __builtin_bit_cast(float, xb_ld((unsigned*)amh + m));
        const float inv = amax > 0.f ? 255.0f / amax : 0.f;
        GAS v2u* dst = (GAS v2u*)(HQ + (size_t)m * FF) + F.lane;
        for (int c0 = 0; c0 < 32; c0 += 8) {
            v4u w[8];
#pragma unroll
            for (int k = 0; k < 8; ++k) w[k] = src[64 * (c0 + k)];
#pragma unroll
            for (int k = 0; k < 8; ++k) { unsigned by[8];
#pragma unroll
                for (int e = 0; e < 4; ++e) { const unsigned u = w[k][e];
                    const float lo = __builtin_bit_cast(float, u << 16), hi = __builtin_bit_cast(float, u & 0xffff0000u);
                    by[2 * e] = (unsigned)((int)__builtin_rintf(fminf(lo * inv, 255.0f)) - 128) & 255u; by[2 * e + 1] = (unsigned)((int)__builtin_rintf(fminf(hi * inv, 255.0f)) - 128) & 255u; }
                v2u o; o.x = by[0] | (by[1] << 8) | (by[2] << 16) | (by[3] << 24); o.y = by[4] | (by[5] << 8) | (by[6] << 16) | (by[7] << 24);
                dst[64 * (c0 + k)] = o; }
        }
        if (F.lane == 0) rowscale[m] = amax * (1.0f / 255.0f);
    }
}

__device__ __forceinline__ void phase_prologue(Frame& F, const Args& a) {
    unsigned char* ws = a.ws;
    LAS float* scr = (LAS float*)(F.lds + F.wave * P0_SCR);
    const int gw = F.vcu * 8 + F.wave, NGW = F.G * 8;
    constexpr int I_POOL = (1024 / 64) * (1024 / 64);
    constexpr int I_WOUT = (VD / 64) * (DM / 64);
    constexpr int I_W2 = (FF / 64) * (DM / 64);
    constexpr int NITEMS = 4 * I_POOL + I_W2 + I_WOUT;
    constexpr int NWS = (PW + 63) / 64;
    for (int st = F.vcu; st < 2 * (FF / 64); st += F.G) { const int layer = st / (FF / 64);
        convert_strip_i8(F, a.in[13] + (size_t)layer * DM * FF, FF, ws + (layer ? WS_W1_1 : WS_W1_0), (float*)(ws + WS_CS) + layer * 16384, st % (FF / 64)); }
    for (int st = F.vcu; st < NWS; st += F.G) convert_strip_i8(F, a.in[6], PW, ws + WS_WIN, (float*)(ws + WS_CS) + 32768, st);
    const bool weighted = (F.G == 256);
    const int nshare = weighted ? (F.vcu < NWS ? 3 : 7) : 1, share0 = weighted ? (F.vcu < NWS ? 3 * F.vcu : 3 * NWS + 7 * (F.vcu - NWS)) : F.vcu, nshares = weighted ? 3 * NWS + 7 * (256 - NWS) : F.G;
    for (int sh = 0; sh < nshare; ++sh)
    for (int it = (share0 + sh) * 8 + F.wave; it < NITEMS; it += nshares * 8) {
        int r = it;
        if (r < 4 * I_POOL) { const int g = r / I_POOL; p0_transpose_item(a.in[4] + (size_t)g * 1024 * 1024, 1024, 1024, (bf16*)(ws + WS_WPOOL) + (size_t)g * 1024 * 1024, scr, r % I_POOL, F.lane); continue; } r -= 4 * I_POOL;
        if (r < I_W2) { p0_transpose_item(a.in[14], FF, DM, (bf16*)(ws + WS_W2_0), scr, r, F.lane); continue; } r -= I_W2;
        p0_transpose_item(a.in[12], VD, DM, (bf16*)(ws + WS_WOUT), scr, r, F.lane);
    }
    { GAS v4u* z = (GAS v4u*)(ws + WS_WIN + (size_t)PW * DM); const int nz = (PWP - PW) * DM / 16;
      for (int i = gw * 64 + F.lane; i < nz; i += NGW * 64) z[i] = (v4u){0u, 0u, 0u, 0u};
      float* cz = (float*)(ws + WS_CS) + 32768 + PW; for (int i = gw * 64 + F.lane; i < PWP - PW; i += NGW * 64) cz[i] = 0.f; }
    const float* x = a.in[0]; float* rstd0 = (float*)(ws + WS_RSTD0);
    for (int m = gw; m < M; m += NGW) {
        const GAS f32x4* xr = (const GAS f32x4*)(x + (size_t)m * DM) + F.lane; float s = 0.f;
#pragma unroll
        for (int j = 0; j < 16; ++j) { const f32x4 v = xr[64 * j]; s += (v.x * v.x + v.y * v.y) + (v.z * v.z + v.w * v.w); }
        s = wave_sum(s);
        if (F.lane == 0) rstd0[m] = 1.0f / sqrtf(s * (1.0f / DM) + EPS);
    }
}
__device__ __forceinline__ void convert_w1_layer1(Frame& F, const Args& a, int first) {
    LAS float* scr = (LAS float*)(F.lds + F.wave * P0_SCR);
    const int nwg = F.G - first, me = (int)blockIdx.x - first;
    if (me < 0 || nwg <= 0) return;
    (void)scr;
    for (int st = me; st < DM / 32; st += nwg) convert_strip32_i8(F, a.in[14] + (size_t)DM * FF, DM, a.ws + WS_W2_1, (float*)(a.ws + WS_CS) + 57344, st, 32);
}

__device__ __forceinline__ void phase_pooldiff(Frame& F, const Args& a) {
    const float* x = a.in[0]; const float* gmix = a.in[1]; const float* rstd0 = (const float*)(a.ws + WS_RSTD0); bf16* D = (bf16*)(a.ws + WS_D);
    for (int it = F.vcu; it < 1024; it += F.G) {
        const int half = it & 1, run = (it >> 1) & 63, b = it >> 7;
        const int c = half * 2048 + F.tid * 4, grp = c >> 10, wh = 1 << grp, t0 = run * 32;
        const f32x4 gv = *(const f32x4*)(gmix + c);
        const float* xb = x + (size_t)b * SEQ * DM + c; const float* rb = rstd0 + b * SEQ;
        f32x4 s = {0.f, 0.f, 0.f, 0.f};
        {
            f32x4 v[16]; float wgt[16];
#pragma unroll
            for (int k = 0; k < 16; ++k) { const int u = t0 - wh + k; const bool ok = (k < 2 * wh) && u >= 0 && u < SEQ; const int uc = u < 0 ? 0 : (u >= SEQ ? SEQ - 1 : u);
                v[k] = *(const f32x4*)(xb + (size_t)uc * DM); wgt[k] = ok ? rb[uc] : 0.f; }
#pragma unroll
            for (int k = 0; k < 16; ++k) s += v[k] * wgt[k];
        }
        for (int tb = 0; tb < 4; ++tb) {
            f32x4 cen[8], ad[8], sb[8]; float wc[8], wa[8], wsb[8];
#pragma unroll
            for (int k = 0; k < 8; ++k) { const int t = t0 + 8 * tb + k; const int ta = t + wh, ts = t - wh; const int tac = ta < SEQ ? ta : SEQ - 1, tsc = ts >= 0 ? ts : 0;
                cen[k] = *(const f32x4*)(xb + (size_t)t * DM); wc[k] = rb[t];
                ad[k] = *(const f32x4*)(xb + (size_t)tac * DM); wa[k] = ta < SEQ ? rb[tac] : 0.f;
                sb[k] = *(const f32x4*)(xb + (size_t)tsc * DM); wsb[k] = ts >= 0 ? rb[tsc] : 0.f; }
#pragma unroll
            for (int k = 0; k < 8; ++k) { const int t = t0 + 8 * tb + k; const int lo = (t - wh) > 0 ? (t - wh) : 0, hi = (t + wh) < SEQ ? (t + wh) : SEQ;
                const float inv = 1.0f / (float)(hi - lo);
                const f32x4 d = (s * inv - cen[k] * wc[k]) * gv;
                v2u w; w.x = pk2(d.x, d.y); w.y = pk2(d.z, d.w);
                *(v2u*)(D + ((size_t)(b * SEQ + t)) * DM + c) = w;
                s += ad[k] * wa[k]; s -= sb[k] * wsb[k]; }
        }
    }
}

#define HD __host__ __device__ __forceinline__
HD int qt_off(int p, int dk) { const int s = dk >> 5, r = dk & 31, a = r >> 4, q = (r >> 2) & 3, i = r & 3; return (((s * 4 + (p >> 4)) * 64) + (p & 15) + 16 * q) * 16 + (4 * a + i) * 2; }
HD int kt_off(int dk, int p) { return ((((dk >> 4) * 2 + (p >> 5)) * 64) + (dk & 15) + 16 * ((p >> 3) & 3)) * 16 + (p & 7) * 2; }
HD int pa_off(int i, int j) { return ((((i >> 4) * 2 + (j >> 5)) * 64) + (i & 15) + 16 * ((j >> 3) & 3)) * 16 + (j & 7) * 2; }
HD int vslot(int p) { return (p & 0x33) | (((p >> 3) & 1) << 2) | (((p >> 2) & 1) << 3); }
HD int v_off(int p, int dvl) { return (dvl >> 4) * 2048 + vslot(p) * 32 + (dvl & 15) * 2; }

typedef float f32x2_t __attribute__((ext_vector_type(2))); typedef __bf16 bf16x2_t __attribute__((ext_vector_type(2)));
typedef short v4i16_t __attribute__((ext_vector_type(4)));
__device__ __forceinline__ unsigned cvtpk(float lo, float hi) { f32x2_t v = {lo, hi}; bf16x2_t b = __builtin_convertvector(v, bf16x2_t); return __builtin_bit_cast(unsigned, b); }
__device__ __forceinline__ float dpp_row_shr(float v, int n) {
    const int iv = __builtin_bit_cast(int, v); int r;
    switch (n) { case 1: r = __builtin_amdgcn_update_dpp(0, iv, 0x111, 0xf, 0xf, true); break; case 2: r = __builtin_amdgcn_update_dpp(0, iv, 0x112, 0xf, 0xf, true); break;
                 case 4: r = __builtin_amdgcn_update_dpp(0, iv, 0x114, 0xf, 0xf, true); break; default: r = __builtin_amdgcn_update_dpp(0, iv, 0x118, 0xf, 0xf, true); break; }
    return __builtin_bit_cast(float, r);
}
__device__ __forceinline__ float wave_scan_incl(float v) {
    v += dpp_row_shr(v, 1); v += dpp_row_shr(v, 2); v += dpp_row_shr(v, 4); v += dpp_row_shr(v, 8);
    v += __builtin_bit_cast(float, __builtin_amdgcn_update_dpp(0, __builtin_bit_cast(int, v), 0x142, 0xa, 0xf, false));
    v += __builtin_bit_cast(float, __builtin_amdgcn_update_dpp(0, __builtin_bit_cast(int, v), 0x143, 0xc, 0xf, false));
    return v;
}
__device__ __forceinline__ float rdlane(float v, int l) { return __builtin_bit_cast(float, __builtin_amdgcn_readlane(__builtin_bit_cast(int, v), l)); }
__device__ __forceinline__ void glds16(const void* gsrc, unsigned lds_dst) { unsigned keep;
    asm volatile("s_mov_b32 %0, m0\n\ts_mov_b32 m0, %2\n\ts_nop 0\n\tglobal_load_lds_dwordx4 %1, off\n\ts_mov_b32 m0, %0" : "=&s"(keep) : "v"(gsrc), "s"(lds_dst) : "memory"); }
#define GLDS16(src, dst) glds16((const void*)(src), (unsigned)(uintptr_t)(dst))

__device__ __forceinline__ void phase_gla_prep(Frame& F, const Args& a) {
    unsigned char* ws = a.ws;
    const bf16* Qb = (const bf16*)(ws + WS_Q); const bf16* Kb = (const bf16*)(ws + WS_K); const float* R = (const float*)(ws + WS_R);
    LAS unsigned char* QS = F.lds; LAS unsigned char* KS = F.lds + 65536; LAS unsigned char* scr = F.lds + 131072 + F.wave * 1024;
    const int w = F.wave, p = F.lane;
    const float qscale = 0.044194173824159216f;
    for (int item = F.vcu; item < BATCH * NH * 2 * 32; item += F.G) {
        const int c = item & 31, dir = (item >> 5) & 1, h = (item >> 6) & 3, b = item >> 8;
        const int tok = b * SEQ + 64 * c + (dir ? 63 - p : p);
        typedef const __attribute__((address_space(4))) float cfloat; typedef const __attribute__((address_space(4))) f32x4 cf32x4;
        cfloat* wup = (cfloat*)(a.in[dir ? 9 : 7] + h * HK + 64 * w);
        cfloat* bup = (cfloat*)(a.in[dir ? 10 : 8] + h * HK + 64 * w);
        unsigned char* QTi = ws + WS_QT + (size_t)item * 65536; unsigned char* KTi = ws + WS_KT + (size_t)item * 65536; unsigned char* PAi = ws + WS_PA + (size_t)item * 10240;
        float* ach = (float*)(PAi + 8192);
        f32x4 rv[4];
#pragma unroll
        for (int j = 0; j < 4; ++j) rv[j] = *(const f32x4*)(R + (size_t)tok * 32 + dir * 16 + 4 * j);
        v4u qraw[8], kraw[8];
#pragma unroll
        for (int j = 0; j < 8; ++j) { qraw[j] = *(const v4u*)(Qb + (size_t)tok * KD + h * HK + 64 * w + 8 * j); kraw[j] = *(const v4u*)(Kb + (size_t)tok * KD + h * HK + 64 * w + 8 * j); }
#pragma unroll
        for (int sl = 0; sl < 2; ++sl)
#pragma unroll
            for (int q = 0; q < 4; ++q) {
                const int s = 2 * w + sl, dl = 32 * sl + 4 * q;
                float x[8];
                { const f32x4 b0 = *(cf32x4*)(bup + dl), b1 = *(cf32x4*)(bup + dl + 16);
                  x[0] = b0.x; x[1] = b0.y; x[2] = b0.z; x[3] = b0.w; x[4] = b1.x; x[5] = b1.y; x[6] = b1.z; x[7] = b1.w; }
#pragma unroll
                for (int r = 0; r < 16; ++r) { const f32x4 w0 = *(cf32x4*)(wup + r * KD + dl), w1 = *(cf32x4*)(wup + r * KD + dl + 16); const float rr = rv[r >> 2][r & 3];
                    x[0] += rr * w0.x; x[1] += rr * w0.y; x[2] += rr * w0.z; x[3] += rr * w0.w; x[4] += rr * w1.x; x[5] += rr * w1.y; x[6] += rr * w1.z; x[7] += rr * w1.w;
                    if ((r & 3) == 3) asm volatile("" ::: "memory"); }
                float qv[8], kv[8];
#pragma unroll
                for (int aa = 0; aa < 2; ++aa) { const v4u qc = qraw[4 * sl + 2 * aa + (q >> 1)], kc = kraw[4 * sl + 2 * aa + (q >> 1)];
                    const unsigned q01 = (q & 1) ? qc.z : qc.x, q23 = (q & 1) ? qc.w : qc.y, k01 = (q & 1) ? kc.z : kc.x, k23 = (q & 1) ? kc.w : kc.y;
                    qv[4 * aa + 0] = bf2f((unsigned short)(q01 & 0xffffu)); qv[4 * aa + 1] = bf2f((unsigned short)(q01 >> 16)); qv[4 * aa + 2] = bf2f((unsigned short)(q23 & 0xffffu)); qv[4 * aa + 3] = bf2f((unsigned short)(q23 >> 16));
                    kv[4 * aa + 0] = bf2f((unsigned short)(k01 & 0xffffu)); kv[4 * aa + 1] = bf2f((unsigned short)(k01 >> 16)); kv[4 * aa + 2] = bf2f((unsigned short)(k23 & 0xffffu)); kv[4 * aa + 3] = bf2f((unsigned short)(k23 >> 16)); }
                float qs_[8], ks_[8], qt_[8], kt_[8], al[8];
#pragma unroll
                for (int e = 0; e < 8; ++e) {
                    const float ls = fminf(x[e], 0.f) - __logf(1.0f + __expf(-fabsf(x[e])));
                    const float bc = wave_scan_incl(ls * (1.0f / 16.0f));
                    const float bm = rdlane(bc, 31), bl = rdlane(bc, 63);
                    const float eb = __expf(bc - bm), ebi = __expf(bm - bc), em = __expf(bm), elm = __expf(bl - bm);
                    qs_[e] = qv[e] * qscale * eb; ks_[e] = kv[e] * ebi; qt_[e] = qs_[e] * em; kt_[e] = ks_[e] * elm; al[e] = em * elm;
                }
                const int off16 = (((s * 4 + (p >> 4)) * 64) + (p & 15) + 16 * q) * 16;
                { v4u t; t.x = cvtpk(qt_[0], qt_[1]); t.y = cvtpk(qt_[2], qt_[3]); t.z = cvtpk(qt_[4], qt_[5]); t.w = cvtpk(qt_[6], qt_[7]); *(GAS v4u*)(QTi + off16) = t; }
                { v4u t; t.x = cvtpk(qs_[0], qs_[1]); t.y = cvtpk(qs_[2], qs_[3]); t.z = cvtpk(qs_[4], qs_[5]); t.w = cvtpk(qs_[6], qs_[7]); *(LAS v4u*)(QS + off16) = t; }
                { v4u t; t.x = cvtpk(ks_[0], ks_[1]); t.y = cvtpk(ks_[2], ks_[3]); t.z = cvtpk(ks_[4], ks_[5]); t.w = cvtpk(ks_[6], ks_[7]); *(LAS v4u*)(KS + off16) = t; }
                if (p == 63) { *(f32x4*)(ach + 32 * s + 4 * q) = (f32x4){al[0], al[1], al[2], al[3]}; *(f32x4*)(ach + 32 * s + 16 + 4 * q) = (f32x4){al[4], al[5], al[6], al[7]}; }
                asm volatile("" ::: "memory");
#pragma unroll
                for (int e = 0; e < 8; ++e) *(LAS unsigned short*)(scr + e * 128 + p * 2) = (unsigned short)(cvtpk(kt_[e], 0.f) & 0xffffu);
                asm volatile("s_waitcnt lgkmcnt(0)" ::: "memory");
                { const int e2 = p >> 3, n = p & 7; const v4u kk = *(const LAS v4u*)(scr + e2 * 128 + n * 16);
                  const int dk = 32 * s + 16 * (e2 >> 2) + 4 * q + (e2 & 3);
                  asm volatile("s_waitcnt lgkmcnt(0)" ::: "memory");
                  *(GAS v4u*)(KTi + kt_off(dk, 8 * n)) = kk; }
            }
        __syncthreads();
        {
            const int mj = w >> 1, mi0 = 2 * (w & 1), fr = p & 15, fq = p >> 4;
            f32x4 acc0 = {0.f, 0.f, 0.f, 0.f}, acc1 = {0.f, 0.f, 0.f, 0.f};
#pragma unroll
            for (int s = 0; s < 16; ++s) {
                const bf16x8 A = *(const LAS bf16x8*)(KS + ((s * 4 + mj) * 64 + p) * 16);
                const bf16x8 B0 = *(const LAS bf16x8*)(QS + ((s * 4 + mi0) * 64 + p) * 16), B1 = *(const LAS bf16x8*)(QS + ((s * 4 + mi0 + 1) * 64 + p) * 16);
                acc0 = __builtin_amdgcn_mfma_f32_16x16x32_bf16(A, B0, acc0, 0, 0, 0); acc1 = __builtin_amdgcn_mfma_f32_16x16x32_bf16(A, B1, acc1, 0, 0, 0);
            }
            const int j0 = 16 * mj + 4 * fq;
            { const int i = 16 * mi0 + fr; v2u t; t.x = cvtpk(j0 <= i ? acc0[0] : 0.f, j0 + 1 <= i ? acc0[1] : 0.f); t.y = cvtpk(j0 + 2 <= i ? acc0[2] : 0.f, j0 + 3 <= i ? acc0[3] : 0.f); *(GAS v2u*)(PAi + pa_off(i, j0)) = t; }
            { const int i = 16 * (mi0 + 1) + fr; v2u t; t.x = cvtpk(j0 <= i ? acc1[0] : 0.f, j0 + 1 <= i ? acc1[1] : 0.f); t.y = cvtpk(j0 + 2 <= i ? acc1[2] : 0.f, j0 + 3 <= i ? acc1[3] : 0.f); *(GAS v2u*)(PAi + pa_off(i, j0)) = t; }
        }
        __syncthreads();
    }
}

constexpr int SCAN_SUB = 32768, SCAN_PV = 26624, SCAN_PV_OFF = 3 * SCAN_SUB;
__device__ __forceinline__ void scan_issue_sub(LAS unsigned char* dst, const unsigned char* ws, int bh, int i, int w, int lane) {
    const int cs = i >> 2, j = i & 3, dir = cs >> 5, cc = cs & 31, c = dir ? 31 - cc : cc;
    const size_t item = (size_t)((bh * 2 + dir) * 32 + c);
    const unsigned char* qsrc = ws + WS_QT + item * 65536 + j * 16384 + lane * 16; const unsigned char* ksrc = ws + WS_KT + item * 65536 + j * 16384 + lane * 16;
    GLDS16(qsrc + w * 1024, dst + w * 1024); GLDS16(qsrc + (w + 8) * 1024, dst + (w + 8) * 1024);
    GLDS16(ksrc + w * 1024, dst + 16384 + w * 1024); GLDS16(ksrc + (w + 8) * 1024, dst + 16384 + (w + 8) * 1024);
}
__device__ __forceinline__ void scan_issue_pv(LAS unsigned char* slot, const unsigned char* ws, int b, int h, int sl, int cs, int k, int w, int lane) {
    const int dir = cs >> 5, cc = cs & 31, c = dir ? 31 - cc : cc;
    const size_t item = (size_t)(((b * 4 + h) * 2 + dir) * 32 + c);
    int idx = w + 8 * k; if (idx >= 26) idx -= 8;
    const unsigned char* src;
    if (idx < 10) src = ws + WS_PA + item * 10240 + idx * 1024 + lane * 16;
    else { const int kk = idx - 10, wblk = kk >> 1, slt = (kk & 1) * 32 + (lane >> 1), half = lane & 1, p = vslot(slt);
           const int tok = b * SEQ + 64 * c + (dir ? 63 - p : p);
           src = ws + WS_V + ((size_t)tok * VD + h * HV + 128 * sl + 16 * wblk + 8 * half) * 2; }
    GLDS16(src, slot + idx * 1024);
}
__device__ __forceinline__ void phase_gla_scan(Frame& F, const Args& a) {
    const unsigned char* ws = a.ws;
    LAS unsigned char* RING = F.lds; LAS unsigned char* PVS = F.lds + SCAN_PV_OFF;
    const int w = F.wave, lane = F.lane, fr = lane & 15, fq = lane >> 4;
    for (int u = F.vcu; u < BATCH * NH * 8; u += F.G) {
        const int sl = u & 7, h = (u >> 3) & 3, b = u >> 5, bh = b * 4 + h;
        f32x4 S[32];
#pragma unroll
        for (int t = 0; t < 32; ++t) S[t] = (f32x4){0.f, 0.f, 0.f, 0.f};
#pragma unroll
        for (int k = 0; k < 4; ++k) scan_issue_pv(PVS, ws, b, h, sl, 0, k, w, lane);
        scan_issue_sub(RING, ws, bh, 0, w, lane); scan_issue_sub(RING + SCAN_SUB, ws, bh, 1, w, lane);
        asm volatile("s_waitcnt vmcnt(4)" ::: "memory"); __builtin_amdgcn_s_barrier();
        int r3 = 0;
        for (int cs = 0; cs < 64; ++cs) {
            const int dir = cs >> 5, cc = cs & 31, c = dir ? 31 - cc : cc;
            if (cs == 32) {
#pragma unroll
                for (int t = 0; t < 32; ++t) S[t] = (f32x4){0.f, 0.f, 0.f, 0.f};
            }
            LAS unsigned char* pv = PVS + (cs & 1) * SCAN_PV;
            LAS unsigned char* pvn = PVS + ((cs + 1) & 1) * SCAN_PV;
            const int ncs = cs + 1 < 64 ? cs + 1 : 63;
            f32x4 o[4]; bf16x8 vB[2];
#pragma unroll
            for (int j = 0; j < 4; ++j) {
                if (j == 0) asm volatile("s_waitcnt vmcnt(20)" ::: "memory"); else asm volatile("s_waitcnt vmcnt(4)" ::: "memory");
                __builtin_amdgcn_s_barrier(); __builtin_amdgcn_sched_barrier(0);
                {
                    scan_issue_pv(pvn, ws, b, h, sl, ncs, j, w, lane);
                    int i2 = 4 * cs + j + 2; if (i2 > 255) i2 = 255;
                    int s3 = r3 + ((j + 2) % 3); if (s3 >= 3) s3 -= 3;
                    scan_issue_sub(RING + s3 * SCAN_SUB, ws, bh, i2, w, lane);
                }
                int c3 = r3 + (j % 3); if (c3 >= 3) c3 -= 3;
                LAS unsigned char* rb = RING + c3 * SCAN_SUB;
                bf16x8 f0[8]; f32x4 a4[4];
                if (j == 0) {
#pragma unroll
                    for (int m = 0; m < 4; ++m) o[m] = (f32x4){0.f, 0.f, 0.f, 0.f};
#pragma unroll
                    for (int s2 = 0; s2 < 2; ++s2) {
                        const LAS unsigned char* vb = pv + 10240 + w * 2048 + (fr & 3) * 8;
                        const v4i16_t lo = __builtin_amdgcn_ds_read_tr16_b64_v4i16((LAS v4i16_t*)(vb + vslot(32 * s2 + 8 * fq + (fr >> 2)) * 32));
                        const v4i16_t hi = __builtin_amdgcn_ds_read_tr16_b64_v4i16((LAS v4i16_t*)(vb + vslot(32 * s2 + 8 * fq + 4 + (fr >> 2)) * 32));
                        vB[s2] = __builtin_shufflevector(lo, hi, 0, 1, 2, 3, 4, 5, 6, 7);
                    }
#pragma unroll
                    for (int k = 0; k < 8; ++k) f0[k] = *(const LAS bf16x8*)(pv + (k * 64 + lane) * 16);
                    __builtin_amdgcn_sched_barrier(0);
#pragma unroll
                    for (int i = 0; i < 8; ++i) {
                        o[i >> 1] = __builtin_amdgcn_mfma_f32_16x16x32_bf16(f0[i], vB[i & 1], o[i >> 1], 0, 0, 0);
                        f0[i] = *(const LAS bf16x8*)(rb + (i * 64 + lane) * 16);
                        __builtin_amdgcn_sched_barrier(0);
                    }
                } else {
#pragma unroll
                    for (int k = 0; k < 8; ++k) f0[k] = *(const LAS bf16x8*)(rb + (k * 64 + lane) * 16);
                    __builtin_amdgcn_sched_barrier(0);
                }
                bf16x8 Bs;
#pragma unroll
                for (int i = 0; i < 16; ++i) {
                    if ((i & 3) == 0) { const int t0 = 8 * j + 2 * (i >> 2);
                        v4u pk; pk.x = cvtpk(S[t0][0], S[t0][1]); pk.y = cvtpk(S[t0][2], S[t0][3]); pk.z = cvtpk(S[t0 + 1][0], S[t0 + 1][1]); pk.w = cvtpk(S[t0 + 1][2], S[t0 + 1][3]);
                        Bs = __builtin_bit_cast(bf16x8, pk); }
                    o[i & 3] = __builtin_amdgcn_mfma_f32_16x16x32_bf16(f0[i & 7], Bs, o[i & 3], 0, 0, 0);
                    f0[i & 7] = (i < 8) ? *(const LAS bf16x8*)(rb + ((i + 8) * 64 + lane) * 16) : *(const LAS bf16x8*)(rb + 16384 + ((i - 8) * 64 + lane) * 16);
                    if (i >= 12) a4[i - 12] = *(const LAS f32x4*)(pv + 8192 + (128 * j + 16 * (i - 12) + 4 * fq) * 4);
                    __builtin_amdgcn_sched_barrier(0);
                }
#pragma unroll
                for (int i = 0; i < 16; ++i) {
                    const int tl = i >> 1, t = 8 * j + tl;
                    if ((i & 1) == 0) S[t] = S[t] * a4[tl & 3];
                    S[t] = __builtin_amdgcn_mfma_f32_16x16x32_bf16(f0[i & 7], vB[i & 1], S[t], 0, 0, 0);
                    if (i < 8) f0[i & 7] = *(const LAS bf16x8*)(rb + 16384 + ((i + 8) * 64 + lane) * 16);
                    if ((i & 1) == 1 && tl < 4) a4[tl] = *(const LAS f32x4*)(pv + 8192 + (128 * j + 16 * (tl + 4) + 4 * fq) * 4);
                    __builtin_amdgcn_sched_barrier(0);
                }
                if (j == 3) {
                    bf16* Od = (bf16*)(a.ws + (dir ? WS_OB : WS_OF)) + (size_t)h * HV + 128 * sl + 16 * w + fr;
#pragma unroll
                    for (int m = 0; m < 4; ++m)
#pragma unroll
                        for (int r = 0; r < 4; ++r) { const int p = 16 * m + 4 * fq + r; const int tok = b * SEQ + 64 * c + (dir ? 63 - p : p); Od[(size_t)tok * VD] = (bf16)(cvtpk(o[m][r], 0.f) & 0xffffu); }
                }
            }
            r3 = r3 + 1; if (r3 == 3) r3 = 0;
        }
        asm volatile("s_waitcnt vmcnt(0)" ::: "memory"); __builtin_amdgcn_s_barrier();
    }
}

__device__ __forceinline__ void phase_post(Frame& F, const Args& a) {
    const bf16* O = (const bf16*)(a.ws + WS_OF); const bf16* O2 = (const bf16*)(a.ws + WS_OB); const bf16* Gt = (const bf16*)(a.ws + WS_G); bf16* XA = (bf16*)(a.ws + WS_D); const float* gn = a.in[11];
    const int gw = F.vcu * 8 + F.wave, NGW = F.G * 8;
    f32x4 gv[4];
#pragma unroll
    for (int j = 0; j < 4; ++j) gv[j] = *(const f32x4*)(gn + F.lane * 4 + 256 * j);
    for (int it = gw; it < M * NH; it += NGW) {
        const size_t base = (size_t)(it >> 2) * VD + (it & 3) * HV + F.lane * 4;
        f32x4 o[4]; float s = 0.f;
#pragma unroll
        for (int j = 0; j < 4; ++j) { const v2u a2 = *(const v2u*)(O + base + 256 * j), b2 = *(const v2u*)(O2 + base + 256 * j);
            o[j].x = bf2f((unsigned short)(a2.x & 0xffffu)) + bf2f((unsigned short)(b2.x & 0xffffu)); o[j].y = bf2f((unsigned short)(a2.x >> 16)) + bf2f((unsigned short)(b2.x >> 16));
            o[j].z = bf2f((unsigned short)(a2.y & 0xffffu)) + bf2f((unsigned short)(b2.y & 0xffffu)); o[j].w = bf2f((unsigned short)(a2.y >> 16)) + bf2f((unsigned short)(b2.y >> 16));
            s += (o[j].x * o[j].x + o[j].y * o[j].y) + (o[j].z * o[j].z + o[j].w * o[j].w); }
        s = wave_sum(s); const float rs = 1.0f / sqrtf(s * (1.0f / HV) + EPS);
#pragma unroll
        for (int j = 0; j < 4; ++j) {
            const v2u gw2 = *(const v2u*)(Gt + base + 256 * j);
            const float g0 = bf2f((unsigned short)(gw2.x & 0xffffu)), g1 = bf2f((unsigned short)(gw2.x >> 16)), g2 = bf2f((unsigned short)(gw2.y & 0xffffu)), g3 = bf2f((unsigned short)(gw2.y >> 16));
            const f32x4 y = o[j] * rs * gv[j];
            const float r0 = y.x * g0 / (1.0f + __expf(-g0)), r1 = y.y * g1 / (1.0f + __expf(-g1)), r2 = y.z * g2 / (1.0f + __expf(-g2)), r3 = y.w * g3 / (1.0f + __expf(-g3));
            v2u w; w.x = pk2(r0, r1); w.y = pk2(r2, r3);
            *(v2u*)(XA + base + 256 * j) = w;
        }
    }
}
__device__ __forceinline__ void phase_final(Frame& F, const Args& a) {
    float* H = a.out; const float* ss = (const float*)(a.ws + WS_CTL) + CW_SS + 3 * M; const float* gf = a.in[3];
    const int gw = F.vcu * 8 + F.wave, NGW = F.G * 8;
    for (int m = gw; m < M; m += NGW) {
        const float rs = 1.0f / sqrtf(ld_agent(ss + m) * (1.0f / DM) + EPS);
        f32x4* hr = (f32x4*)(H + (size_t)m * DM) + F.lane;
#pragma unroll
        for (int j = 0; j < 16; ++j) { const f32x4 g = *((const f32x4*)gf + F.lane + 64 * j); hr[64 * j] = hr[64 * j] * rs * g; }
    }
}

__device__ __forceinline__ void final_norm_own_tiles(Frame& F, const Args& a, const pg8::StaticOrder& S, unsigned* ctl) {
    pg8::Unit u0; if (!S.next(0, u0)) return;
    asm volatile("s_waitcnt vmcnt(0)" ::: "memory");
    __syncthreads();
    if (F.tid == 0) {
        unsigned* cnt = ctl + CW_PAN + 64 * u0.pm; unsigned* bar = ctl + CW_BAR;
        __builtin_amdgcn_fence(__ATOMIC_RELEASE, "agent");
        asm volatile("s_waitcnt vmcnt(0)" ::: "memory");
        (void)xb_add(cnt, 1u);
        XB_SPIN(xb_ld(cnt) < 4u, bar);
        __builtin_amdgcn_fence(__ATOMIC_ACQUIRE, "agent");
        asm volatile("s_waitcnt vmcnt(0)" ::: "memory");
    }
    __syncthreads();
    float* H = a.out; const float* ss = (const float*)(a.ws + WS_CTL) + CW_SS + 3 * M; const float* gf = a.in[3];
    pg8::Unit u;
    for (int i = 0; S.next(i, u); ++i) {
        const f32x4 g = *(const f32x4*)(gf + u.pn * 256 + F.lane * 4);
        for (int r0 = 0; r0 < 256; r0 += 64) {
            f32x4 v[8]; float sq[8];
#pragma unroll
            for (int k = 0; k < 8; ++k) { const int row = u.pm * 256 + r0 + 8 * k + F.wave;
                sq[k] = ld_agent(ss + row); v[k] = *((const f32x4*)(H + (size_t)row * DM + u.pn * 256) + F.lane); }
#pragma unroll
            for (int k = 0; k < 8; ++k) { const int row = u.pm * 256 + r0 + 8 * k + F.wave; const float rs = 1.0f / sqrtf(sq[k] * (1.0f / DM) + EPS);
                *((f32x4*)(H + (size_t)row * DM + u.pn * 256) + F.lane) = v[k] * rs * g; }
        }
    }
}

struct EpiResidFin {
    static constexpr bool PERM = true, AFTER_DRAIN = false;
    float* H; float* ss; const float* gf; unsigned* ctl; int tid;
    __device__ __forceinline__ void pre(const pg8::Unit&, int, int, float (&p)[8]) const { _Pragma("unroll") for (int i = 0; i < 8; ++i) p[i] = 0.f; }
    __device__ __forceinline__ void operator()(f32x4 (&acc)[2][2][4][2], const pg8::Unit& u, int wr, int wc, int fr, int fq, const float (&)[8]) const {
        using namespace pg8;
        const int row0 = u.pm * BM + wr * 64 + fr, col0 = u.pn * BM + wc * 32 + 8 * fq;
        const bool lastu = u.pn >= 12;
#pragma unroll
        for (int ai = 0; ai < 2; ++ai)
#pragma unroll
            for (int m = 0; m < 4; ++m) {
                const int r = row0 + ai * HALF + m * 16; const size_t off = (size_t)r * DM + col0; float s = 0.f;
#pragma unroll
                for (int bj = 0; bj < 2; ++bj) {
                    const f32x4 h0 = *(const f32x4*)(H + off + bj * HALF), h1 = *(const f32x4*)(H + off + bj * HALF + 4);
                    const f32x4 v0 = h0 + acc[ai][bj][m][0], v1 = h1 + acc[ai][bj][m][1];
                    if (lastu) { acc[ai][bj][m][0] = v0; acc[ai][bj][m][1] = v1; }
                    else { *(f32x4*)(H + off + bj * HALF) = v0; *(f32x4*)(H + off + bj * HALF + 4) = v1; }
                    s += (v0[0] * v0[0] + v0[1] * v0[1]) + (v0[2] * v0[2] + v0[3] * v0[3]) + (v1[0] * v1[0] + v1[1] * v1[1]) + (v1[2] * v1[2] + v1[3] * v1[3]);
                }
                s += __shfl_xor(s, 16); s += __shfl_xor(s, 32);
                if (fq == 0) unsafeAtomicAdd(ss + r, s);
                if (m & 1) asm volatile("" ::: "memory");
            }
        if (!lastu) return;
        asm volatile("s_waitcnt vmcnt(0)" ::: "memory");
        __syncthreads();
        if (tid == 0) {
            unsigned* cnt = ctl + CW_PAN + 64 * u.pm; unsigned* bar = ctl + CW_BAR;
            __builtin_amdgcn_fence(__ATOMIC_RELEASE, "agent");
            asm volatile("s_waitcnt vmcnt(0)" ::: "memory");
            (void)xb_add(cnt, 1u);
            XB_SPIN(xb_ld(cnt) < 4u, bar);
            __builtin_amdgcn_fence(__ATOMIC_ACQUIRE, "agent");
            asm volatile("s_waitcnt vmcnt(0)" ::: "memory");
        }
        __syncthreads();
        f32x4 g[2][2];
#pragma unroll
        for (int bj = 0; bj < 2; ++bj)
#pragma unroll
            for (int n = 0; n < 2; ++n) g[bj][n] = *(const f32x4*)(gf + col0 + bj * HALF + 4 * n);
#pragma unroll
        for (int ai = 0; ai < 2; ++ai)
#pragma unroll
            for (int m = 0; m < 4; ++m) {
                const int r = row0 + ai * HALF + m * 16; const size_t off = (size_t)r * DM + col0;
                const float rs = 1.0f / sqrtf(ld_agent(ss + r) * (1.0f / DM) + EPS);
#pragma unroll
                for (int bj = 0; bj < 2; ++bj) { *(f32x4*)(H + off + bj * HALF) = acc[ai][bj][m][0] * rs * g[bj][0]; *(f32x4*)(H + off + bj * HALF + 4) = acc[ai][bj][m][1] * rs * g[bj][1]; }
            }
    }
};
__device__ __forceinline__ void final_norm_rest(Frame& F, const Args& a, const pg8::StaticOrder& S) {
    asm volatile("s_waitcnt vmcnt(0)" ::: "memory");
    __syncthreads();
    float* H = a.out; const float* ss = (const float*)(a.ws + WS_CTL) + CW_SS + 3 * M; const float* gf = a.in[3];
    pg8::Unit u;
    for (int i = 0; S.next(i, u); ++i) {
        if (u.pn >= 12) continue;
        const f32x4 g = *(const f32x4*)(gf + u.pn * 256 + F.lane * 4);
        for (int r0 = 0; r0 < 256; r0 += 64) {
            f32x4 v[8]; float sq[8];
#pragma unroll
            for (int k = 0; k < 8; ++k) { const int row = u.pm * 256 + r0 + 8 * k + F.wave;
                sq[k] = ld_agent(ss + row); v[k] = *((const f32x4*)(H + (size_t)row * DM + u.pn * 256) + F.lane); }
#pragma unroll
            for (int k = 0; k < 8; ++k) { const int row = u.pm * 256 + r0 + 8 * k + F.wave; const float rs = 1.0f / sqrtf(sq[k] * (1.0f / DM) + EPS);
                *((f32x4*)(H + (size_t)row * DM + u.pn * 256) + F.lane) = v[k] * rs * g; }
        }
    }
}

struct EpiResidI8 {
    static constexpr bool PERM = true, AFTER_DRAIN = false;
    float* H; const float* rsc; const float* cscl; const int* coff; float* ss; const float* gf; unsigned* ctl; int tid, fin;
    __device__ __forceinline__ void pre(const pg8::Unit& u, int wr, int fr, float (&p)[8]) const { const int row0 = u.pm * pg8::BM + wr * 64 + fr;
        _Pragma("unroll") for (int i = 0; i < 8; ++i) p[i] = rsc[row0 + (i >> 2) * pg8::HALF + (i & 3) * 16]; }
    __device__ __forceinline__ void operator()(i32x4 (&acc)[2][2][4][2], const pg8::Unit& u, int wr, int wc, int fr, int fq, const float (&p)[8]) const {
        using namespace pg8;
        const int row0 = u.pm * BM + wr * 64 + fr, col0 = u.pn * BM + wc * 32 + 8 * fq;
        const bool lastu = fin && u.pn >= 12;
#pragma unroll
        for (int ai = 0; ai < 2; ++ai)
#pragma unroll
            for (int m = 0; m < 4; ++m) {
                const int r = row0 + ai * HALF + m * 16; const size_t off = (size_t)r * DM + col0; float s = 0.f; const float rsf = p[ai * 4 + m];
#pragma unroll
                for (int bj = 0; bj < 2; ++bj) {
                    const f32x4 h0 = *(const f32x4*)(H + off + bj * HALF), h1 = *(const f32x4*)(H + off + bj * HALF + 4);
                    const f32x4 c0 = *(const f32x4*)(cscl + col0 + bj * HALF), c1 = *(const f32x4*)(cscl + col0 + bj * HALF + 4);
                    const i32x4 o0 = *(const i32x4*)(coff + col0 + bj * HALF), o1 = *(const i32x4*)(coff + col0 + bj * HALF + 4);
                    const f32x4 v0 = h0 + __builtin_convertvector(acc[ai][bj][m][0] + o0, f32x4) * (c0 * rsf);
                    const f32x4 v1 = h1 + __builtin_convertvector(acc[ai][bj][m][1] + o1, f32x4) * (c1 * rsf);
                    if (!lastu) { *(f32x4*)(H + off + bj * HALF) = v0; *(f32x4*)(H + off + bj * HALF + 4) = v1; }
                    acc[ai][bj][m][0] = __builtin_bit_cast(i32x4, v0); acc[ai][bj][m][1] = __builtin_bit_cast(i32x4, v1);
                    s += (v0[0] * v0[0] + v0[1] * v0[1]) + (v0[2] * v0[2] + v0[3] * v0[3]) + (v1[0] * v1[0] + v1[1] * v1[1]) + (v1[2] * v1[2] + v1[3] * v1[3]);
                }
                if (ss) { s += __shfl_xor(s, 16); s += __shfl_xor(s, 32); if (fq == 0) unsafeAtomicAdd(ss + r, s); }
                if (m & 1) asm volatile("" ::: "memory");
            }
        if (!lastu) return;
        asm volatile("s_waitcnt vmcnt(0)" ::: "memory");
        __syncthreads();
        if (tid == 0) {
            unsigned* cnt = ctl + CW_PAN + 64 * u.pm; unsigned* bar = ctl + CW_BAR;
            __builtin_amdgcn_fence(__ATOMIC_RELEASE, "agent");
            asm volatile("s_waitcnt vmcnt(0)" ::: "memory");
            (void)xb_add(cnt, 1u);
            XB_SPIN(xb_ld(cnt) < 4u, bar);
            __builtin_amdgcn_fence(__ATOMIC_ACQUIRE, "agent");
            asm volatile("s_waitcnt vmcnt(0)" ::: "memory");
        }
        __syncthreads();
        f32x4 g[2][2];
#pragma unroll
        for (int bj = 0; bj < 2; ++bj)
#pragma unroll
            for (int n = 0; n < 2; ++n) g[bj][n] = *(const f32x4*)(gf + col0 + bj * HALF + 4 * n);
#pragma unroll
        for (int ai = 0; ai < 2; ++ai)
#pragma unroll
            for (int m = 0; m < 4; ++m) {
                const int r = row0 + ai * HALF + m * 16; const size_t off = (size_t)r * DM + col0;
                const float rs = 1.0f / sqrtf(ld_agent(ss + r) * (1.0f / DM) + EPS);
#pragma unroll
                for (int bj = 0; bj < 2; ++bj) { *(f32x4*)(H + off + bj * HALF) = __builtin_bit_cast(f32x4, acc[ai][bj][m][0]) * rs * g[bj][0]; *(f32x4*)(H + off + bj * HALF + 4) = __builtin_bit_cast(f32x4, acc[ai][bj][m][1]) * rs * g[bj][1]; }
            }
    }
};

__global__ void __launch_bounds__(512, 2) mk_fwd(Args args) {
    extern __shared__ __attribute__((aligned(16))) unsigned char lds[];
    Frame F;
    F.lds = (LAS unsigned char*)lds;
    F.tid = threadIdx.x; F.lane = F.tid & 63; F.wave = __builtin_amdgcn_readfirstlane(F.tid >> 6);
    F.G = gridDim.x; { const int bx = blockIdx.x; F.vcu = (F.G % 8 == 0) ? (bx % 8) * (F.G / 8) + bx / 8 : bx; }
    volatile LAS unsigned* MISC = (volatile LAS unsigned*)(F.lds + MISC_OFF);
    if (F.tid < 64) MISC[F.tid] = 0u;
    __syncthreads();
    unsigned char* ws = args.ws;
    unsigned* ctl = (unsigned*)(ws + WS_CTL);
    const int lo = args.ph_lo, hi = args.ph_hi;
    XcdBarrier bar; bar.bar = ctl + CW_BAR; bar.x = 0; bar.st = nullptr;
    if (hi - lo > 1) bar = xcd_barrier_post(ctl + CW_BAR, MISC + 8);
#define IN(k) (lo <= (k) && (k) < hi)
#define SEAM(k) do { if ((PROBE_MASK >> (k)) & 1u) { const unsigned long long _t1 = __builtin_amdgcn_s_memrealtime(), _d = _t1 - pt0; while (__builtin_amdgcn_s_memrealtime() - _t1 < _d) __builtin_amdgcn_s_sleep(8); } \
    if (IN(k) && IN((k) + 1)) xcd_barrier(bar); if (PROBE_MASK) pt0 = __builtin_amdgcn_s_memrealtime(); } while (0)
    unsigned long long pt0 = PROBE_MASK ? __builtin_amdgcn_s_memrealtime() : 0ull;
    float* SS = (float*)ctl + CW_SS;
    float* H = args.out;
    bf16* XN = (bf16*)(ws + WS_XN); bf16* Db = (bf16*)(ws + WS_D); bf16* HID = (bf16*)(ws + WS_HID);
    const float* norm_mix = args.in[1]; const float* norm_mlp = args.in[2];

    unsigned char* XQ = ws + WS_XN;
    float* RS = (float*)(ws + WS_RS); const float* CS = (const float*)(ws + WS_CS);
    const bool fused_final = IN(15) && IN(16) && F.G == 256;
    if (IN(0)) { phase_prologue(F, args); } SEAM(0);
    if (IN(1)) {
        phase_pooldiff(F, args); } SEAM(1);
    if (IN(2)) {
        pg8::Gemm g{Db, (const bf16*)(ws + WS_WPOOL), M, DM, 1024, DM, 4}; pg8::StaticOrder S; S.init(M, DM, F.G, (int)blockIdx.x);
        pg8::EpiResid E{args.in[0], H, args.in[5], nullptr, nullptr, nullptr, DM, 1};
        pg8::gemm_phase<pg8::EpiResid, pg8::StaticOrder>(F.lds, g, S, E);
    } SEAM(2);
    if (IN(3)) { phase_quant(F, H, norm_mlp, XQ, RS + 0 * M); } SEAM(3);
    if (IN(4)) {
        pg8::Gemm g{(const bf16*)XQ, (const bf16*)(ws + WS_W1_0), M, FF, DM / 2, DM / 2, 0}; pg8::StaticOrder S; S.init(M, FF, F.G, (int)blockIdx.x);
        pg8::EpiRelu2Q E{HID, FF, RS + 0 * M, CS, nullptr};
        pg8::gemm_phase<pg8::EpiRelu2Q, pg8::StaticOrder, true, true>(F.lds, g, S, E);
    } SEAM(4);
    if (IN(5)) {
        pg8::Gemm g{HID, (const bf16*)(ws + WS_W2_0), M, DM, FF, FF, 0}; pg8::StaticOrder S; S.init(M, DM, F.G, (int)blockIdx.x);
        pg8::EpiResid E{H, H, nullptr, nullptr, nullptr, nullptr, DM, 0};
        pg8::gemm_phase<pg8::EpiResid, pg8::StaticOrder>(F.lds, g, S, E);
    } SEAM(5);
    if (IN(6)) { phase_quant(F, H, norm_mix + DM, XQ, RS + 1 * M); } SEAM(6);
    if (IN(7)) {
        pg8::Gemm g{(const bf16*)XQ, (const bf16*)(ws + WS_WIN), M, PWP, DM / 2, DM / 2, 0}; pg8::StaticOrder S; S.init(M, PWP, F.G, (int)blockIdx.x);
        pg8::EpiInProjQ E{(bf16*)(ws + WS_Q), (bf16*)(ws + WS_K), (bf16*)(ws + WS_V), (bf16*)(ws + WS_G), (float*)(ws + WS_R), RS + 1 * M, CS + 32768};
        pg8::gemm_phase<pg8::EpiInProjQ, pg8::StaticOrder, true, true>(F.lds, g, S, E);
        const int n13 = (M / 256) * (PWP / 256) - 12 * F.G;
        if (F.G == 256) convert_w1_layer1(F, args, n13); else convert_w1_layer1(F, args, 0);
    } SEAM(7);
    if (IN(8)) { phase_gla_prep(F, args); } SEAM(8);
    if (IN(9)) { phase_gla_scan(F, args); } SEAM(9);
    if (IN(10)) { phase_post(F, args); } SEAM(10);
    if (IN(11)) {
        pg8::Gemm g{Db, (const bf16*)(ws + WS_WOUT), M, DM, VD, VD, 0}; pg8::StaticOrder S; S.init(M, DM, F.G, (int)blockIdx.x);
        pg8::EpiResid E{H, H, nullptr, nullptr, nullptr, nullptr, DM, 1};
        pg8::gemm_phase<pg8::EpiResid, pg8::StaticOrder>(F.lds, g, S, E);
    } SEAM(11);
    if (IN(12)) { phase_quant(F, H, norm_mlp + DM, XQ, RS + 2 * M); } SEAM(12);
    if (IN(13)) {
        pg8::Gemm g{(const bf16*)XQ, (const bf16*)(ws + WS_W1_1), M, FF, DM / 2, DM / 2, 0}; pg8::StaticOrder S; S.init(M, FF, F.G, (int)blockIdx.x);
        pg8::EpiRelu2Q E{HID, FF, RS + 2 * M, CS + 16384, (unsigned*)(SS + 0 * M)};
        pg8::gemm_phase<pg8::EpiRelu2Q, pg8::StaticOrder, true, true>(F.lds, g, S, E);
    } SEAM(13);
    if (IN(14)) { phase_quant_hid(F, HID, (const unsigned*)(SS + 0 * M), ws + WS_HIDQ, (float*)(ws + WS_RSTD0));
        {
            float* cs2 = (float*)(ws + WS_CS) + 49152; int* co2 = (int*)(ws + WS_CS) + 53248;
            for (int n = F.vcu * 8 + F.wave; n < DM; n += F.G * 8) {
                const GAS v4u* rowp = (const GAS v4u*)(ws + WS_W2_1 + (size_t)n * FF) + F.lane; int sq = 0;
#pragma unroll
                for (int j = 0; j < 16; ++j) { const v4u w = rowp[64 * j];
#pragma unroll
                    for (int e = 0; e < 4; ++e) { const int u = (int)w[e]; sq += (int)(signed char)(u & 255) + (int)(signed char)((u >> 8) & 255) + (int)(signed char)((u >> 16) & 255) + (u >> 24); } }
#pragma unroll
                for (int o = 1; o < 64; o <<= 1) sq += __shfl_xor(sq, o);
                if (F.lane == 0) { cs2[n] = ((const float*)(ws + WS_CS))[57344 + n]; co2[n] = 128 * sq; }
            } }
    } SEAM(14);
    if (IN(15)) {
        pg8::Gemm g{(const bf16*)(ws + WS_HIDQ), (const bf16*)(ws + WS_W2_1), M, DM, FF / 2, FF / 2, 0}; pg8::StaticOrder S; S.init(M, DM, F.G, (int)blockIdx.x);
        EpiResidI8 E{H, (const float*)(ws + WS_RSTD0), (const float*)(ws + WS_CS) + 49152, (const int*)(ws + WS_CS) + 53248, SS + 3 * M, args.in[3], ctl, F.tid, fused_final ? 1 : 0};
        pg8::gemm_phase<EpiResidI8, pg8::StaticOrder, true, true>(F.lds, g, S, E);
        if (fused_final) final_norm_rest(F, args, S);
    } if (!fused_final) SEAM(15);
    if (IN(16) && !fused_final) { phase_final(F, args); } SEAM(16);
#undef IN
#undef SEAM
}

extern "C" void kernel_launch(void* const* d_in, const int* in_sizes, int n_in, void* d_out, int out_size, void* d_ws, size_t ws_size, hipStream_t stream) {
    static int grid = 0;
    if (grid == 0) {
        if (n_in != 15 || in_sizes[0] != M * DM || out_size != M * DM || ws_size < WS_END) {
            fprintf(stderr, "kernel_launch: unexpected problem (n_in %d, in0 %d, out %d, ws %zu < %zu); nothing launched\n", n_in, n_in > 0 ? in_sizes[0] : -1, out_size, ws_size, (size_t)WS_END); grid = -1; return; }
        int dev = 0, cus = 0;
        if (hipGetDevice(&dev) != hipSuccess || hipDeviceGetAttribute(&cus, hipDeviceAttributeMultiprocessorCount, dev) != hipSuccess) { grid = -1; return; }
        if (hipFuncSetAttribute((const void*)mk_fwd, hipFuncAttributeMaxDynamicSharedMemorySize, LDS_BYTES) != hipSuccess) { fprintf(stderr, "kernel_launch: hipFuncSetAttribute failed\n"); grid = -1; return; }
        int per_cu = 0;
        if (hipOccupancyMaxActiveBlocksPerMultiprocessor(&per_cu, (const void*)mk_fwd, 512, LDS_BYTES) != hipSuccess || per_cu < 1) fprintf(stderr, "kernel_launch: occupancy query says %d\n", per_cu);
        (void)hipGetLastError();
        grid = cus;
    }
    if (grid < 0) return;
    (void)hipMemsetAsync((char*)d_ws + WS_CTL, 0, CTL_ZERO_BYTES, stream);
    Args a{};
    for (int i = 0; i < 15; ++i) a.in[i] = (const float*)d_in[i];
    a.out = (float*)d_out; a.ws = (unsigned char*)d_ws;
#if MK_PER_PHASE
    for (int p = 0; p < NPHASE; ++p) { a.ph_lo = p; a.ph_hi = p + 1; hipLaunchKernelGGL(mk_fwd, dim3(grid), dim3(512), LDS_BYTES, stream, a); }
#else
    a.ph_lo = 0; a.ph_hi = NPHASE; hipLaunchKernelGGL(mk_fwd, dim3(grid), dim3(512), LDS_BYTES, stream, a);
#endif
}
```

```cpp
#include <hip/hip_runtime.h>
#include <cstdio>
#include <cstdint>

#ifndef MK_PER_PHASE
#define MK_PER_PHASE 0
#endif
#ifndef PROBE_MASK
#define PROBE_MASK 0u
#endif

constexpr int BATCH = 8, SEQ = 2048, DM = 4096, M = BATCH * SEQ, FF = 4 * DM;
constexpr int NH = 4, KD = DM / 2, VD = DM, HK = KD / NH, HV = VD / NH, GR = 16;
constexpr int PW = 2 * KD + 2 * VD + 2 * GR;
constexpr int PWP = 12544;
constexpr float EPS = 1e-6f;
constexpr int NPHASE = 17;

constexpr size_t MiB = 1u << 20;
constexpr size_t WS_CTL = 0, CTL_ZERO_BYTES = 1 * MiB;
constexpr size_t WS_WPOOL = 2 * MiB;
constexpr size_t WS_WOUT = 10 * MiB;
constexpr size_t WS_WIN = 42 * MiB;
constexpr size_t WS_W1_0 = 140 * MiB, WS_W1_1 = 396 * MiB;
constexpr size_t WS_W2_0 = 268 * MiB, WS_W2_1 = 524 * MiB;
constexpr size_t WS_OB = 140 * MiB;
constexpr size_t WS_XN = 652 * MiB;
constexpr size_t WS_D = 780 * MiB;
constexpr size_t WS_HID = 908 * MiB;
constexpr size_t WS_Q = 908 * MiB;
constexpr size_t WS_K = 972 * MiB;
constexpr size_t WS_V = 1036 * MiB;
constexpr size_t WS_G = 1164 * MiB;
constexpr size_t WS_R = 1292 * MiB;
constexpr size_t WS_QT = 1294 * MiB;
constexpr size_t WS_KT = 1422 * MiB;
constexpr size_t WS_PA = 1550 * MiB;
constexpr size_t WS_OF = 1570 * MiB;
constexpr size_t WS_HIDQ = 1550 * MiB;
constexpr size_t WS_RSTD0 = 1826 * MiB;
constexpr size_t WS_RS = WS_RSTD0 + 65536, WS_CS = WS_RSTD0 + 262144;
constexpr size_t WS_END = 1827 * MiB;
constexpr int CW_BAR = 4096;
constexpr int CW_PAN = 12288;
constexpr int CW_SS = 131072;

constexpr int LDS_BYTES = 159 * 1024;
constexpr int RING_BYTES = 131072;
constexpr int MISC_OFF = LDS_BYTES - 256;

#define GAS __attribute__((address_space(1)))
#define LAS __attribute__((address_space(3)))
typedef unsigned short bf16;
typedef unsigned v4u __attribute__((ext_vector_type(4)));
typedef unsigned v2u __attribute__((ext_vector_type(2)));
typedef float f32x4 __attribute__((ext_vector_type(4)));
typedef short bf16x8 __attribute__((ext_vector_type(8)));
typedef int i32x4 __attribute__((ext_vector_type(4)));
#define LDS_WAIT() asm volatile("s_waitcnt lgkmcnt(0)" ::: "memory")
#define VM_WAIT() asm volatile("s_waitcnt vmcnt(0)" ::: "memory")
__device__ __forceinline__ unsigned f2bf(float f) { unsigned u = __builtin_bit_cast(unsigned, f); return (u + 0x7fffu + ((u >> 16) & 1u)) >> 16; }
__device__ __forceinline__ unsigned pk2(float lo, float hi) { return f2bf(lo) | (f2bf(hi) << 16); }
__device__ __forceinline__ float bf2f(unsigned short b) { return __builtin_bit_cast(float, ((unsigned)b) << 16); }
__device__ __forceinline__ float ld_agent(const float* p) { return __builtin_bit_cast(float, __hip_atomic_load((const unsigned*)p, __ATOMIC_RELAXED, __HIP_MEMORY_SCOPE_AGENT)); }

namespace pg8 {
#define PG8_LAS __attribute__((address_space(3)))
typedef unsigned short bf16_t;
typedef unsigned u32x4 __attribute__((ext_vector_type(4)));
constexpr int BM = 256, BK = 64, HALF = 128, HTB = HALF * BK * 2, STAGE_BYTES = 8 * HTB, NXCD = 8, WGM = 8;

__host__ __device__ __forceinline__ int lds_byte(int r, int c) { const int st = (r >> 4) * 2 + (c >> 5), rr = r & 15, cc = c & 31, ob = rr * 64 + cc * 2; return st * 1024 + (ob ^ (((ob >> 9) & 1) << 5)); }
__host__ __device__ __forceinline__ void stage_rc(int b, int& R, int& C) { const int st = b / 1024, sb = b % 1024, swz = sb ^ (((sb >> 9) & 1) << 5); R = (st >> 1) * 16 + swz / 64; C = (st & 1) * 32 + (swz % 64) / 2; }
__host__ __device__ __forceinline__ int perm32(int rho) { const int n = rho >> 4, i = rho & 15; return 8 * (i >> 2) + 4 * n + (i & 3); }

struct Unit { int pm, pn; };
struct Gemm { const bf16_t* A; const bf16_t* Bt; int M, N, K, lda, grp; };

struct StaticOrder {
    int nM, nN, nwg, G, c;
    __host__ __device__ void init(int M_, int N_, int G_, int c_) { nM = M_ / BM; nN = N_ / BM; nwg = nM * nN; G = G_; c = c_; }
    __host__ __device__ bool next(int i, Unit& u) const {
        const long L = (long)i * G + c; if (L >= nwg) return false;
        int wgid = (int)L; { const int q = nwg / NXCD, r = nwg % NXCD, xcd = wgid % NXCD, off = wgid / NXCD; wgid = (xcd < r ? xcd * (q + 1) : r * (q + 1) + (xcd - r) * q) + off; }
        const int nig = WGM * nN, gid = wgid / nig, fm = gid * WGM, gsz = (nM - fm) < WGM ? (nM - fm) : WGM;
        u.pm = fm + ((wgid % nig) % gsz); u.pn = (wgid % nig) / gsz; return true;
    }
    __device__ __forceinline__ void a_ready(const Unit&) const {}
    __device__ __forceinline__ void done(const Unit&) const {}
};

__device__ __forceinline__ unsigned cvt_pk_bf16(float lo, float hi) { unsigned r; asm volatile("v_cvt_pk_bf16_f32 %0, %1, %2" : "=v"(r) : "v"(lo), "v"(hi)); return r; }


struct EpiResid {
    static constexpr bool PERM = true, AFTER_DRAIN = false;
    const float* hin; float* hout; const float* cscale; const float* gnext; bf16_t* xn; float* ss; int ldc; int deep;
    __device__ __forceinline__ void pre(const Unit&, int, int, float (&p)[8]) const { _Pragma("unroll") for (int i = 0; i < 8; ++i) p[i] = 0.f; }
    __device__ __forceinline__ void operator()(const f32x4 (&acc)[2][2][4][2], const Unit& u, int wr, int wc, int fr, int fq, const float (&)[8]) const {
        const int row0 = u.pm * BM + wr * 64 + fr, col0 = u.pn * BM + wc * 32 + 8 * fq;
        f32x4 sc[2][2], gn[2][2];
#pragma unroll
        for (int bj = 0; bj < 2; ++bj)
#pragma unroll
            for (int n = 0; n < 2; ++n) {
                sc[bj][n] = cscale ? *(const f32x4*)(cscale + col0 + bj * HALF + 4 * n) : (f32x4){1.f, 1.f, 1.f, 1.f};
                gn[bj][n] = gnext ? *(const f32x4*)(gnext + col0 + bj * HALF + 4 * n) : (f32x4){1.f, 1.f, 1.f, 1.f};
            }
#pragma unroll
        for (int ai = 0; ai < 2; ++ai)
#pragma unroll
            for (int m = 0; m < 4; ++m) {
                const int r = row0 + ai * HALF + m * 16; const size_t off = (size_t)r * ldc + col0; float s = 0.f;
#pragma unroll
                for (int bj = 0; bj < 2; ++bj) {
                    const f32x4 h0 = *(const f32x4*)(hin + off + bj * HALF), h1 = *(const f32x4*)(hin + off + bj * HALF + 4);
                    const f32x4 v0 = h0 + acc[ai][bj][m][0] * sc[bj][0], v1 = h1 + acc[ai][bj][m][1] * sc[bj][1];
                    *(f32x4*)(hout + off + bj * HALF) = v0; *(f32x4*)(hout + off + bj * HALF + 4) = v1;
                    s += (v0[0] * v0[0] + v0[1] * v0[1]) + (v0[2] * v0[2] + v0[3] * v0[3]) + (v1[0] * v1[0] + v1[1] * v1[1]) + (v1[2] * v1[2] + v1[3] * v1[3]);
                    if (xn) { const f32x4 a = v0 * gn[bj][0], b = v1 * gn[bj][1]; u32x4 w; w.x = cvt_pk_bf16(a[0], a[1]); w.y = cvt_pk_bf16(a[2], a[3]); w.z = cvt_pk_bf16(b[0], b[1]); w.w = cvt_pk_bf16(b[2], b[3]);
                        *(u32x4*)(xn + off + bj * HALF) = w; }
                }
                s += __shfl_xor(s, 16); s += __shfl_xor(s, 32);
                if (ss && fq == 0) unsafeAtomicAdd(ss + r, s);
                if (deep ? (m == 3) : (m & 1)) asm volatile("" ::: "memory");
            }
    }
};
struct EpiRelu2 {
    static constexpr bool PERM = true, AFTER_DRAIN = false;
    bf16_t* O; int ldc; const float* ss;
    __device__ __forceinline__ void pre(const Unit& u, int wr, int fr, float (&p)[8]) const { const int row0 = u.pm * BM + wr * 64 + fr;
        _Pragma("unroll") for (int i = 0; i < 8; ++i) p[i] = ld_agent(ss + row0 + (i >> 2) * HALF + (i & 3) * 16); }
    __device__ __forceinline__ void operator()(const f32x4 (&acc)[2][2][4][2], const Unit& u, int wr, int wc, int fr, int fq, const float (&p)[8]) const {
        const int row0 = u.pm * BM + wr * 64 + fr, col0 = u.pn * BM + wc * 32 + 8 * fq;
#pragma unroll
        for (int ai = 0; ai < 2; ++ai)
#pragma unroll
            for (int m = 0; m < 4; ++m) {
                const int r = row0 + ai * HALF + m * 16; const float rs = 1.0f / sqrtf(p[ai * 4 + m] * (1.0f / DM) + EPS);
                bf16_t* rowp = O + (size_t)r * ldc + col0;
#pragma unroll
                for (int bj = 0; bj < 2; ++bj) { f32x4 v0 = acc[ai][bj][m][0] * rs, v1 = acc[ai][bj][m][1] * rs;
#pragma unroll
                    for (int j = 0; j < 4; ++j) { const float a = fmaxf(v0[j], 0.f), b = fmaxf(v1[j], 0.f); v0[j] = a * a; v1[j] = b * b; }
                    u32x4 w; w.x = cvt_pk_bf16(v0[0], v0[1]); w.y = cvt_pk_bf16(v0[2], v0[3]); w.z = cvt_pk_bf16(v1[0], v1[1]); w.w = cvt_pk_bf16(v1[2], v1[3]);
                    *(u32x4*)(rowp + bj * HALF) = w; }
            }
    }
};
struct EpiRelu2Q {
    static constexpr bool PERM = true, AFTER_DRAIN = false;
    bf16_t* O; int ldc; const float* rsc; const float* csc; unsigned* amh;
    __device__ __forceinline__ void pre(const Unit& u, int wr, int fr, float (&p)[8]) const { const int row0 = u.pm * BM + wr * 64 + fr;
        _Pragma("unroll") for (int i = 0; i < 8; ++i) p[i] = rsc[row0 + (i >> 2) * HALF + (i & 3) * 16]; }
    __device__ __forceinline__ void operator()(const i32x4 (&acc)[2][2][4][2], const Unit& u, int wr, int wc, int fr, int fq, const float (&p)[8]) const {
        const int row0 = u.pm * BM + wr * 64 + fr, col0 = u.pn * BM + wc * 32 + 8 * fq;
        f32x4 cs[2][2];
#pragma unroll
        for (int bj = 0; bj < 2; ++bj)
#pragma unroll
            for (int n = 0; n < 2; ++n) cs[bj][n] = *(const f32x4*)(csc + col0 + bj * HALF + 4 * n);
#pragma unroll
        for (int ai = 0; ai < 2; ++ai)
#pragma unroll
            for (int m = 0; m < 4; ++m) {
                const int r = row0 + ai * HALF + m * 16; const float rs = p[ai * 4 + m]; float mxr = 0.f;
                bf16_t* rowp = O + (size_t)r * ldc + col0;
#pragma unroll
                for (int bj = 0; bj < 2; ++bj) { f32x4 v0 = __builtin_convertvector(acc[ai][bj][m][0], f32x4) * (cs[bj][0] * rs), v1 = __builtin_convertvector(acc[ai][bj][m][1], f32x4) * (cs[bj][1] * rs);
#pragma unroll
                    for (int j = 0; j < 4; ++j) { const float a = fmaxf(v0[j], 0.f), b = fmaxf(v1[j], 0.f); v0[j] = a * a; v1[j] = b * b; mxr = fmaxf(mxr, fmaxf(v0[j], v1[j])); }
                    u32x4 w; w.x = cvt_pk_bf16(v0[0], v0[1]); w.y = cvt_pk_bf16(v0[2], v0[3]); w.z = cvt_pk_bf16(v1[0], v1[1]); w.w = cvt_pk_bf16(v1[2], v1[3]);
                    *(u32x4*)(rowp + bj * HALF) = w; }
                if (amh) { mxr = fmaxf(mxr, __shfl_xor(mxr, 16)); mxr = fmaxf(mxr, __shfl_xor(mxr, 32));
                    if (fq == 0) (void)__hip_atomic_fetch_max(amh + r, __builtin_bit_cast(unsigned, mxr), __ATOMIC_RELAXED, __HIP_MEMORY_SCOPE_AGENT); }
            }
    }
};
struct EpiInProj {
    static constexpr bool PERM = true, AFTER_DRAIN = false;
    bf16_t *Q, *K, *V, *G; float* R; const float* ss;
    __device__ __forceinline__ void pre(const Unit& u, int wr, int fr, float (&p)[8]) const { const int row0 = u.pm * BM + wr * 64 + fr;
        _Pragma("unroll") for (int i = 0; i < 8; ++i) p[i] = ld_agent(ss + row0 + (i >> 2) * HALF + (i & 3) * 16); }
    __device__ __forceinline__ void operator()(const f32x4 (&acc)[2][2][4][2], const Unit& u, int wr, int wc, int fr, int fq, const float (&p)[8]) const {
        const int row0 = u.pm * BM + wr * 64 + fr; const int pn = u.pn;
        bf16_t* base; int ldc, colt;
        if (pn < 8) { base = Q; ldc = KD; colt = pn * BM; } else if (pn < 16) { base = K; ldc = KD; colt = (pn - 8) * BM; }
        else if (pn < 32) { base = V; ldc = VD; colt = (pn - 16) * BM; } else { base = G; ldc = VD; colt = (pn - 32) * BM; }
        const int col0 = colt + wc * 32 + 8 * fq;
#pragma unroll
        for (int ai = 0; ai < 2; ++ai)
#pragma unroll
            for (int m = 0; m < 4; ++m) {
                const int r = row0 + ai * HALF + m * 16; const float rs = 1.0f / sqrtf(p[ai * 4 + m] * (1.0f / DM) + EPS);
                if (pn < 48) {
                    bf16_t* rowp = base + (size_t)r * ldc + col0;
#pragma unroll
                    for (int bj = 0; bj < 2; ++bj) { const f32x4 v0 = acc[ai][bj][m][0] * rs, v1 = acc[ai][bj][m][1] * rs;
                        u32x4 w; w.x = cvt_pk_bf16(v0[0], v0[1]); w.y = cvt_pk_bf16(v0[2], v0[3]); w.z = cvt_pk_bf16(v1[0], v1[1]); w.w = cvt_pk_bf16(v1[2], v1[3]);
                        *(u32x4*)(rowp + bj * HALF) = w; }
                } else if (wc == 0) {
                    float* rp = R + (size_t)r * 32 + 8 * fq;
                    *(f32x4*)rp = acc[ai][0][m][0] * rs; *(f32x4*)(rp + 4) = acc[ai][0][m][1] * rs;
                }
            }
    }
};

struct EpiInProjQ {
    static constexpr bool PERM = true, AFTER_DRAIN = false;
    bf16_t *Q, *K, *V, *G; float* R; const float* rsc; const float* csc;
    __device__ __forceinline__ void pre(const Unit& u, int wr, int fr, float (&p)[8]) const { const int row0 = u.pm * BM + wr * 64 + fr;
        _Pragma("unroll") for (int i = 0; i < 8; ++i) p[i] = rsc[row0 + (i >> 2) * HALF + (i & 3) * 16]; }
    __device__ __forceinline__ void operator()(const i32x4 (&acc)[2][2][4][2], const Unit& u, int wr, int wc, int fr, int fq, const float (&p)[8]) const {
        const int row0 = u.pm * BM + wr * 64 + fr; const int pn = u.pn;
        bf16_t* base; int ldc, colt;
        if (pn < 8) { base = Q; ldc = KD; colt = pn * BM; } else if (pn < 16) { base = K; ldc = KD; colt = (pn - 8) * BM; }
        else if (pn < 32) { base = V; ldc = VD; colt = (pn - 16) * BM; } else { base = G; ldc = VD; colt = (pn - 32) * BM; }
        const int col0 = colt + wc * 32 + 8 * fq, ccol = pn * BM + wc * 32 + 8 * fq;
        f32x4 cs[2][2];
#pragma unroll
        for (int bj = 0; bj < 2; ++bj)
#pragma unroll
            for (int n = 0; n < 2; ++n) cs[bj][n] = *(const f32x4*)(csc + ccol + bj * HALF + 4 * n);
#pragma unroll
        for (int ai = 0; ai < 2; ++ai)
#pragma unroll
            for (int m = 0; m < 4; ++m) {
                const int r = row0 + ai * HALF + m * 16; const float rs = p[ai * 4 + m];
                if (pn < 48) {
                    bf16_t* rowp = base + (size_t)r * ldc + col0;
#pragma unroll
                    for (int bj = 0; bj < 2; ++bj) { const f32x4 v0 = __builtin_convertvector(acc[ai][bj][m][0], f32x4) * (cs[bj][0] * rs), v1 = __builtin_convertvector(acc[ai][bj][m][1], f32x4) * (cs[bj][1] * rs);
                        u32x4 w; w.x = cvt_pk_bf16(v0[0], v0[1]); w.y = cvt_pk_bf16(v0[2], v0[3]); w.z = cvt_pk_bf16(v1[0], v1[1]); w.w = cvt_pk_bf16(v1[2], v1[3]);
                        *(u32x4*)(rowp + bj * HALF) = w; }
                } else if (wc == 0) {
                    float* rp = R + (size_t)r * 32 + 8 * fq;
                    *(f32x4*)rp = __builtin_convertvector(acc[ai][0][m][0], f32x4) * (cs[0][0] * rs); *(f32x4*)(rp + 4) = __builtin_convertvector(acc[ai][0][m][1], f32x4) * (cs[0][1] * rs);
                }
            }
    }
};

template <bool I8> struct AccT { typedef f32x4 t; };
template <> struct AccT<true> { typedef i32x4 t; };
template <class Epi, class Sched, bool ALIGN_EPI = true, bool I8 = false>
__device__ __forceinline__ void gemm_phase(PG8_LAS unsigned char* lds, const Gemm g, const Sched& S, const Epi& E) {
    const int tid = threadIdx.x, wid = __builtin_amdgcn_readfirstlane(tid >> 6), lane = tid & 63, wr = wid >> 2, wc = wid & 3, fr = lane & 15, fq = lane >> 4;
    const int K = g.K, nt = K / BK, lda = g.lda;
    unsigned voffA[2], voffB[2];
#pragma unroll
    for (int i = 0; i < 2; ++i) { int R, C; stage_rc(tid * 16 + i * 8192, R, C); const int Rb = Epi::PERM ? ((R & ~31) + perm32(R & 31)) : R;
        voffA[i] = (unsigned)(R * lda + C) * 2u; voffB[i] = (unsigned)(Rb * K + C) * 2u; }
    const size_t kstep = (size_t)(BK * 2);
    const size_t hstepA = (size_t)HALF * lda * 2, hstepB = (size_t)HALF * K * 2;
    const size_t tstepA = 2 * hstepA, tstepB = 2 * hstepB;
    const unsigned ldsw = (unsigned)wid * 1024u;
    const unsigned ldsbase = (unsigned)(uintptr_t)lds;
    const int aoff = lds_byte(wr * 64 + fr, fq * 8), boff = lds_byte(wc * 32 + fr, fq * 8);
#define PG8_SA(b, h) (((b) * 2 + (h)) * HTB)
#define PG8_SB(b, h) ((4 + (b) * 2 + (h)) * HTB)
#define PG8_STAGE(bufoff, gbase, voff) do { _Pragma("unroll") for (int _i = 0; _i < 2; ++_i) { unsigned _keep; \
        asm volatile("s_mov_b32 %0, m0\n\ts_mov_b32 m0, %3\n\ts_nop 0\n\tglobal_load_lds_dwordx4 %1, %2\n\ts_mov_b32 m0, %0" \
            : "=&s"(_keep) : "v"((voff)[_i]), "s"((const char*)(gbase)), "s"(ldsbase + (unsigned)(bufoff) + ldsw + (unsigned)(_i * 8192)) : "memory"); } } while (0)
#define PG8_LDA(dst, b, h) do { _Pragma("unroll") for (int m = 0; m < 4; ++m) _Pragma("unroll") for (int k = 0; k < 2; ++k) dst[m][k] = *(const PG8_LAS bf16x8*)(lds + PG8_SA(b, h) + aoff + m * 2048 + k * 1024); } while (0)
#define PG8_LDB(dst, b, h) do { _Pragma("unroll") for (int n = 0; n < 2; ++n) _Pragma("unroll") for (int k = 0; k < 2; ++k) dst[n][k] = *(const PG8_LAS bf16x8*)(lds + PG8_SB(b, h) + boff + n * 2048 + k * 1024); } while (0)
#define PG8_MMA(ai, bj, At, Bt) do { _Pragma("unroll") for (int m = 0; m < 4; ++m) _Pragma("unroll") for (int n = 0; n < 2; ++n) _Pragma("unroll") for (int k = 0; k < 2; ++k) \
        { if constexpr (I8) acc[ai][bj][m][n] = __builtin_amdgcn_mfma_i32_16x16x64_i8(__builtin_bit_cast(i32x4, Bt[n][k]), __builtin_bit_cast(i32x4, At[m][k]), acc[ai][bj][m][n], 0, 0, 0); \
          else acc[ai][bj][m][n] = __builtin_amdgcn_mfma_f32_16x16x32_bf16(Bt[n][k], At[m][k], acc[ai][bj][m][n], 0, 0, 0); } } while (0)
#define PG8_PRIO(p) __builtin_amdgcn_s_setprio(p)
#define PG8_WAIT_V(n) asm volatile("s_waitcnt vmcnt(" #n ")" ::: "memory")
#define PG8_WAIT_L(n) asm volatile("s_waitcnt lgkmcnt(" #n ")" ::: "memory")
#define PG8_BAR __builtin_amdgcn_s_barrier()
#define PG8_SCHED __builtin_amdgcn_sched_barrier(0)
#define PG8_AOFF(u) ((size_t)(u).pm * tstepA + (g.grp ? (size_t)((u).pn / g.grp) * (size_t)K * 2 : (size_t)0))
    Unit cur, nxt; int ui = 0;
    if (!S.next(0, cur)) return;
    typedef typename AccT<I8>::t acc_t;
    acc_t acc[2][2][4][2];
#pragma unroll
    for (int a = 0; a < 2; ++a)
#pragma unroll
        for (int b = 0; b < 2; ++b)
#pragma unroll
            for (int m = 0; m < 4; ++m)
#pragma unroll
                for (int n = 0; n < 2; ++n) acc[a][b][m][n] = (acc_t)(0);
    bf16x8 At[4][2], B0[2][2], B1[2][2];
    const char* cA = (const char*)g.A + PG8_AOFF(cur); const char* cB = (const char*)g.Bt + (size_t)cur.pn * tstepB;
    S.a_ready(cur);
    float pre[8]; E.pre(cur, wr, fr, pre);
    PG8_STAGE(PG8_SB(0, 0), cB, voffB); PG8_STAGE(PG8_SB(0, 1), cB + hstepB, voffB); PG8_STAGE(PG8_SA(0, 0), cA, voffA); PG8_STAGE(PG8_SA(0, 1), cA + hstepA, voffA);
    if (wr == 1) PG8_BAR;
    PG8_WAIT_V(2); PG8_BAR;
    PG8_STAGE(PG8_SB(1, 0), cB + kstep, voffB); PG8_STAGE(PG8_SA(1, 0), cA + kstep, voffA); PG8_STAGE(PG8_SB(1, 1), cB + hstepB + kstep, voffB);
    PG8_WAIT_V(6); PG8_BAR;
    for (;;) {
        const bool has_next = S.next(ui + 1, nxt);
        const char* nA = has_next ? (const char*)g.A + PG8_AOFF(nxt) : cA; const char* nB = has_next ? (const char*)g.Bt + (size_t)nxt.pn * tstepB : cB;
        for (int t = 0; t < nt; t += 2) {
            const bool last = (t == nt - 2);
            const char* a1 = cA + (size_t)(t + 1) * kstep;
            const char* a2 = last ? nA : cA + (size_t)(t + 2) * kstep; const char* b2 = last ? nB : cB + (size_t)(t + 2) * kstep;
            const char* a3 = a2 + kstep; const char* b3 = b2 + kstep;
            if (last && has_next) S.a_ready(nxt);
            PG8_LDB(B0, 0, 0); PG8_LDB(B1, 0, 1); PG8_SCHED; PG8_LDA(At, 0, 0); PG8_STAGE(PG8_SA(1, 1), a1 + hstepA, voffA);
            PG8_WAIT_V(8); PG8_WAIT_L(0); PG8_PRIO(1); PG8_BAR; PG8_MMA(0, 0, At, B0); PG8_MMA(0, 1, At, B1); PG8_PRIO(0); PG8_BAR; PG8_SCHED;
            PG8_LDA(At, 0, 1); PG8_STAGE(PG8_SB(0, 0), b2, voffB); PG8_STAGE(PG8_SB(0, 1), b2 + hstepB, voffB); PG8_STAGE(PG8_SA(0, 0), a2, voffA);
            PG8_WAIT_V(8); PG8_WAIT_L(0); PG8_PRIO(1); PG8_BAR; PG8_MMA(1, 0, At, B0); PG8_MMA(1, 1, At, B1); PG8_PRIO(0); PG8_BAR; PG8_SCHED;
            PG8_LDB(B0, 1, 0); PG8_LDB(B1, 1, 1); PG8_SCHED; PG8_LDA(At, 1, 0); PG8_STAGE(PG8_SA(0, 1), a2 + hstepA, voffA);
            PG8_WAIT_V(8); PG8_WAIT_L(0); PG8_PRIO(1); PG8_BAR; PG8_MMA(0, 0, At, B0); PG8_MMA(0, 1, At, B1); PG8_PRIO(0); PG8_BAR; PG8_SCHED;
            PG8_LDA(At, 1, 1); PG8_STAGE(PG8_SB(1, 0), b3, voffB); PG8_STAGE(PG8_SB(1, 1), b3 + hstepB, voffB); PG8_STAGE(PG8_SA(1, 0), a3, voffA);
            PG8_WAIT_V(8); PG8_WAIT_L(0); PG8_PRIO(1); PG8_BAR; PG8_MMA(1, 0, At, B0); PG8_MMA(1, 1, At, B1); PG8_PRIO(0); PG8_BAR; PG8_SCHED;
        }
        if constexpr (ALIGN_EPI) { if (wr == 0) PG8_BAR; }
        E(acc, cur, wr, wc, fr, fq, pre); S.done(cur);
        if (!has_next) break;
#pragma unroll
        for (int a = 0; a < 2; ++a)
#pragma unroll
            for (int b = 0; b < 2; ++b)
#pragma unroll
                for (int m = 0; m < 4; ++m)
#pragma unroll
                    for (int n = 0; n < 2; ++n) acc[a][b][m][n] = (acc_t)(0);
        cur = nxt; cA = nA; cB = nB; ++ui;
        E.pre(cur, wr, fr, pre);
        if constexpr (ALIGN_EPI) { if (wr == 1) PG8_BAR; }
    }
    PG8_WAIT_V(0);
    if constexpr (!ALIGN_EPI) { if (wr == 0) PG8_BAR; }
    PG8_BAR;
#undef PG8_SA
#undef PG8_SB
#undef PG8_STAGE
#undef PG8_LDA
#undef PG8_LDB
#undef PG8_MMA
#undef PG8_PRIO
#undef PG8_WAIT_V
#undef PG8_WAIT_L
#undef PG8_BAR
#undef PG8_SCHED
#undef PG8_AOFF
}
}

#define XB_TMO      128
#define XB_XCNT(j)  (256  + 64 * (j))
#define XB_XSUB(j)  (1280 + 64 * (j))
#define XB_XGEN(j)  (2304 + 64 * (j))
#define XB_TOP      3328
#define XB_TOPGEN   3392
#define XCD_BAR_WORDS 3456
#define XB_SPIN_CAP (1u << 18)

__device__ __forceinline__ unsigned xb_ld(unsigned* p)              { return __hip_atomic_load(p, __ATOMIC_RELAXED, __HIP_MEMORY_SCOPE_AGENT); }
__device__ __forceinline__ unsigned xb_add(unsigned* p, unsigned v) { return __hip_atomic_fetch_add(p, v, __ATOMIC_RELAXED, __HIP_MEMORY_SCOPE_AGENT); }
__device__ __forceinline__ unsigned xb_xcc_id() { return (unsigned)__builtin_amdgcn_s_getreg((3 << 11) | 20) & 0xFu; }
#define XB_SPIN(cond, bar) do { unsigned _sp = 0; while (cond) { __builtin_amdgcn_s_sleep(1); \
    if ((++_sp & 255u) == 0u) { if (xb_ld(&(bar)[XB_TMO])) break; if (_sp > XB_SPIN_CAP) { atomicAdd(&(bar)[XB_TMO], 1u); break; } } } } while (0)

struct XcdBarrier { unsigned* bar; unsigned x; volatile LAS unsigned* st; };

__device__ __forceinline__ XcdBarrier xcd_barrier_post(unsigned* bar, volatile LAS unsigned* st) {
    XcdBarrier b; b.bar = bar; b.x = xb_xcc_id(); b.st = st;
    if (threadIdx.x == 0) (void)xb_add(&bar[XB_XCNT(b.x)], 1u);
    return b;
}
__device__ __forceinline__ void xcd_barrier_complete(unsigned* bar, unsigned x, unsigned& nloc, unsigned& nx) {
    const unsigned G = gridDim.x * gridDim.y * gridDim.z;
    unsigned sum, cnt, mine, sp = 0u;
    for (;;) {
        sum = 0u; cnt = 0u; mine = 0u;
#pragma unroll
        for (unsigned j = 0; j < 16; ++j) { const unsigned c = xb_ld(&bar[XB_XCNT(j)]); sum += c; cnt += (c > 0u) ? 1u : 0u; mine = (j == x) ? c : mine; }
        if (sum == G) break;
        __builtin_amdgcn_s_sleep(1);
        if ((++sp & 255u) == 0u) { if (xb_ld(&bar[XB_TMO])) break; if (sp > XB_SPIN_CAP) { atomicAdd(&bar[XB_TMO], 1u); break; } }
    }
    nloc = mine > 0u ? mine : 1u; nx = cnt > 0u ? cnt : 1u;
}
__device__ __forceinline__ void xcd_barrier(const XcdBarrier& b) {
    asm volatile("s_waitcnt vmcnt(0)" ::: "memory");
    __syncthreads();
    if (threadIdx.x == 0) {
        unsigned* bar = b.bar;
        __builtin_amdgcn_s_waitcnt(0);
        unsigned nloc = b.st[0], nx = b.st[1];
        if (nloc == 0u) { xcd_barrier_complete(bar, b.x, nloc, nx); b.st[0] = nloc; b.st[1] = nx; }
        const unsigned old = xb_add(&bar[XB_XSUB(b.x)], 1u);
        const unsigned gen = old / nloc;
        if (old + 1u == (gen + 1u) * nloc) {
            __builtin_amdgcn_fence(__ATOMIC_RELEASE, "agent");
            asm volatile("s_waitcnt vmcnt(0)" ::: "memory");
            const unsigned og = xb_add(&bar[XB_TOP], 1u);
            const unsigned tg = og / nx;
            if (og + 1u == (tg + 1u) * nx) xb_add(&bar[XB_TOPGEN], 1u);
            else XB_SPIN(xb_ld(&bar[XB_TOPGEN]) == tg, bar);
            __builtin_amdgcn_fence(__ATOMIC_ACQUIRE, "agent");
            xb_add(&bar[XB_XGEN(b.x)], 1u);
            asm volatile("s_waitcnt vmcnt(0)" ::: "memory");
        } else {
            XB_SPIN(xb_ld(&bar[XB_XGEN(b.x)]) == gen, bar);
            __builtin_amdgcn_fence(__ATOMIC_ACQUIRE, "agent");
            asm volatile("s_waitcnt vmcnt(0)" ::: "memory");
        }
    }
    __syncthreads();
}

struct Args { const float* in[15]; float* out; unsigned char* ws; int ph_lo, ph_hi; };
struct Frame {
    LAS unsigned char* lds;
    int tid, lane, wave, vcu, G;
};
__device__ __forceinline__ float wave_sum(float v) {
#pragma unroll
    for (int o = 1; o < 64; o <<= 1) v += __shfl_xor(v, o);
    return v;
}
__device__ __forceinline__ void p0_transpose_item(const float* W, int K, int N, bf16* WT, LAS float* scr, int item, int lane) {
    const int nblk = (N + 63) / 64, kb = item / nblk, nb = item % nblk, k0 = 64 * kb, n0 = 64 * nb;
    const int nn = 4 * (lane & 15);
    f32x4 v[16];
#pragma unroll
    for (int i = 0; i < 16; ++i) { const int kk = 4 * i + (lane >> 4); v[i] = (n0 + nn < N) ? *(const GAS f32x4*)(W + (size_t)(k0 + kk) * N + n0 + nn) : (f32x4){0.f, 0.f, 0.f, 0.f}; }
#pragma unroll
    for (int i = 0; i < 16; ++i) { const int kk = 4 * i + (lane >> 4); LAS float* d = scr + kk * 65 + nn; d[0] = v[i].x; d[1] = v[i].y; d[2] = v[i].z; d[3] = v[i].w; }
    LDS_WAIT(); asm volatile("" ::: "memory");
    const int c = lane & 7;
#pragma unroll
    for (int j = 0; j < 8; ++j) { const int n = (lane >> 3) + 8 * j; const LAS float* s = scr + (8 * c) * 65 + n;
        v4u o; o.x = pk2(s[0 * 65], s[1 * 65]); o.y = pk2(s[2 * 65], s[3 * 65]); o.z = pk2(s[4 * 65], s[5 * 65]); o.w = pk2(s[6 * 65], s[7 * 65]);
        if (n0 + n < N) *(GAS v4u*)(WT + (size_t)(n0 + n) * K + k0 + 8 * c) = o; }
    LDS_WAIT(); asm volatile("" ::: "memory");
}
constexpr int P0_SCR = 64 * 65 * 4;

__device__ __forceinline__ float wave_max(float v) {
#pragma unroll
    for (int o = 1; o < 64; o <<= 1) v = fmaxf(v, __shfl_xor(v, o));
    return v;
}
__device__ __forceinline__ unsigned q8(float v) { return (unsigned)(int)__builtin_rintf(v) & 0xffu; }
__device__ __forceinline__ void convert_strip_i8(Frame& F, const float* W, int N, unsigned char* WT, float* colscale, int strip, int KT = 8) {
    LAS float* scr = (LAS float*)(F.lds + F.wave * P0_SCR);
    LAS float* part = (LAS float*)(F.lds + 8 * P0_SCR);
    const int n0 = 64 * strip, nn = 4 * (F.lane & 15), lane = F.lane;
    const bool okc = n0 + nn < N;
    f32x4 am = {0.f, 0.f, 0.f, 0.f};
    for (int t = 0; t < KT; ++t) {
        const int k0 = 64 * (KT * F.wave + t);
        f32x4 v[16];
#pragma unroll
        for (int i = 0; i < 16; ++i) { const int kk = 4 * i + (lane >> 4); v[i] = okc ? *(const GAS f32x4*)(W + (size_t)(k0 + kk) * N + n0 + nn) : (f32x4){0.f, 0.f, 0.f, 0.f}; }
#pragma unroll
        for (int i = 0; i < 16; ++i) { am.x = fmaxf(am.x, fabsf(v[i].x)); am.y = fmaxf(am.y, fabsf(v[i].y)); am.z = fmaxf(am.z, fabsf(v[i].z)); am.w = fmaxf(am.w, fabsf(v[i].w)); }
    }
#pragma unroll
    for (int o = 16; o < 64; o <<= 1) { am.x = fmaxf(am.x, __shfl_xor(am.x, o)); am.y = fmaxf(am.y, __shfl_xor(am.y, o)); am.z = fmaxf(am.z, __shfl_xor(am.z, o)); am.w = fmaxf(am.w, __shfl_xor(am.w, o)); }
    if (lane < 16) *(LAS f32x4*)(part + F.wave * 64 + nn) = am;
    __syncthreads();
    f32x4 cm = {0.f, 0.f, 0.f, 0.f};
#pragma unroll
    for (int w = 0; w < 8; ++w) { const f32x4 p = *(const LAS f32x4*)(part + w * 64 + nn); cm.x = fmaxf(cm.x, p.x); cm.y = fmaxf(cm.y, p.y); cm.z = fmaxf(cm.z, p.z); cm.w = fmaxf(cm.w, p.w); }
    if (F.wave == 0 && lane < 16 && okc) *(f32x4*)(colscale + n0 + nn) = cm * (1.0f / 127.0f);
    f32x4 inv; inv.x = cm.x > 0.f ? 127.0f / cm.x : 0.f; inv.y = cm.y > 0.f ? 127.0f / cm.y : 0.f; inv.z = cm.z > 0.f ? 127.0f / cm.z : 0.f; inv.w = cm.w > 0.f ? 127.0f / cm.w : 0.f;
    const int c = lane & 7;
    for (int t = 0; t < KT; ++t) {
        const int k0 = 64 * (KT * F.wave + t);
        f32x4 v[16];
#pragma unroll
        for (int i = 0; i < 16; ++i) { const int kk = 4 * i + (lane >> 4); v[i] = okc ? *(const GAS f32x4*)(W + (size_t)(k0 + kk) * N + n0 + nn) : (f32x4){0.f, 0.f, 0.f, 0.f}; }
#pragma unroll
        for (int i = 0; i < 16; ++i) { const int kk = 4 * i + (lane >> 4); LAS float* d = scr + kk * 65 + nn; const f32x4 q = v[i] * inv; d[0] = q.x; d[1] = q.y; d[2] = q.z; d[3] = q.w; }
        LDS_WAIT(); asm volatile("" ::: "memory");
#pragma unroll
        for (int j = 0; j < 8; ++j) { const int n = (lane >> 3) + 8 * j; const LAS float* sp = scr + (8 * c) * 65 + n;
            v2u o; o.x = q8(sp[0 * 65]) | (q8(sp[1 * 65]) << 8) | (q8(sp[2 * 65]) << 16) | (q8(sp[3 * 65]) << 24);
            o.y = q8(sp[4 * 65]) | (q8(sp[5 * 65]) << 8) | (q8(sp[6 * 65]) << 16) | (q8(sp[7 * 65]) << 24);
            if (n0 + n < N) *(GAS v2u*)(WT + (size_t)(n0 + n) * (512 * KT) + k0 + 8 * c) = o; }
        LDS_WAIT(); asm volatile("" ::: "memory");
    }
    __syncthreads();
}
__device__ __forceinline__ void convert_strip32_i8(Frame& F, const float* W, int N, unsigned char* WT, float* colscale, int strip, int KT) {
    LAS float* scr = (LAS float*)(F.lds + F.wave * P0_SCR);
    LAS float* part = (LAS float*)(F.lds + 8 * P0_SCR);
    const int lane = F.lane, n0 = 32 * strip, nn = 4 * (lane & 7), kr = lane >> 3;
    f32x4 am = {0.f, 0.f, 0.f, 0.f};
    for (int t = 0; t < KT; ++t) {
        const int k0 = 64 * (KT * F.wave + t);
        f32x4 v[8];
#pragma unroll
        for (int i = 0; i < 8; ++i) v[i] = *(const GAS f32x4*)(W + (size_t)(k0 + 8 * i + kr) * N + n0 + nn);
#pragma unroll
        for (int i = 0; i < 8; ++i) { am.x = fmaxf(am.x, fabsf(v[i].x)); am.y = fmaxf(am.y, fabsf(v[i].y)); am.z = fmaxf(am.z, fabsf(v[i].z)); am.w = fmaxf(am.w, fabsf(v[i].w)); }
    }
#pragma unroll
    for (int o = 8; o < 64; o <<= 1) { am.x = fmaxf(am.x, __shfl_xor(am.x, o)); am.y = fmaxf(am.y, __shfl_xor(am.y, o)); am.z = fmaxf(am.z, __shfl_xor(am.z, o)); am.w = fmaxf(am.w, __shfl_xor(am.w, o)); }
    if (lane < 8) *(LAS f32x4*)(part + F.wave * 32 + nn) = am;
    __syncthreads();
    f32x4 cm = {0.f, 0.f, 0.f, 0.f};
#pragma unroll
    for (int w = 0; w < 8; ++w) { const f32x4 p = *(const LAS f32x4*)(part + w * 32 + nn); cm.x = fmaxf(cm.x, p.x); cm.y = fmaxf(cm.y, p.y); cm.z = fmaxf(cm.z, p.z); cm.w = fmaxf(cm.w, p.w); }
    if (F.wave == 0 && lane < 8) *(f32x4*)(colscale + n0 + nn) = cm * (1.0f / 127.0f);
    f32x4 inv; inv.x = cm.x > 0.f ? 127.0f / cm.x : 0.f; inv.y = cm.y > 0.f ? 127.0f / cm.y : 0.f; inv.z = cm.z > 0.f ? 127.0f / cm.z : 0.f; inv.w = cm.w > 0.f ? 127.0f / cm.w : 0.f;
    const int c = lane & 7;
    for (int t = 0; t < KT; ++t) {
        const int k0 = 64 * (KT * F.wave + t);
        f32x4 v[8];
#pragma unroll
        for (int i = 0; i < 8; ++i) v[i] = *(const GAS f32x4*)(W + (size_t)(k0 + 8 * i + kr) * N + n0 + nn);
#pragma unroll
        for (int i = 0; i < 8; ++i) { LAS float* d = scr + (8 * i + kr) * 33 + nn; const f32x4 q = v[i] * inv; d[0] = q.x; d[1] = q.y; d[2] = q.z; d[3] = q.w; }
        LDS_WAIT(); asm volatile("" ::: "memory");
#pragma unroll
        for (int j = 0; j < 4; ++j) { const int n = (lane >> 3) + 8 * j; const LAS float* sp = scr + (8 * c) * 33 + n;
            v2u o; o.x = q8(sp[0 * 33]) | (q8(sp[1 * 33]) << 8) | (q8(sp[2 * 33]) << 16) | (q8(sp[3 * 33]) << 24);
            o.y = q8(sp[4 * 33]) | (q8(sp[5 * 33]) << 8) | (q8(sp[6 * 33]) << 16) | (q8(sp[7 * 33]) << 24);
            *(GAS v2u*)(WT + (size_t)(n0 + n) * (512 * KT) + k0 + 8 * c) = o; }
        LDS_WAIT(); asm volatile("" ::: "memory");
    }
    __syncthreads();
}
__device__ __forceinline__ void phase_quant(Frame& F, const float* H, const float* g, unsigned char* XQ, float* rowscale) {
    const int gw = F.vcu * 8 + F.wave, NGW = F.G * 8;
    f32x4 gv[16];
#pragma unroll
    for (int j = 0; j < 16; ++j) gv[j] = *((const f32x4*)g + F.lane + 64 * j);
    for (int m = gw; m < M; m += NGW) {
        const GAS f32x4* hr = (const GAS f32x4*)(H + (size_t)m * DM) + F.lane;
        f32x4 v[16]; float s = 0.f, mx = 0.f;
#pragma unroll
        for (int j = 0; j < 16; ++j) v[j] = hr[64 * j];
#pragma unroll
        for (int j = 0; j < 16; ++j) { s += (v[j].x * v[j].x + v[j].y * v[j].y) + (v[j].z * v[j].z + v[j].w * v[j].w); v[j] = v[j] * gv[j];
            mx = fmaxf(fmaxf(mx, fmaxf(fabsf(v[j].x), fabsf(v[j].y))), fmaxf(fabsf(v[j].z), fabsf(v[j].w))); }
        s = wave_sum(s); mx = wave_max(mx);
        const float inv = mx > 0.f ? 127.0f / mx : 0.f;
        GAS unsigned* dst = (GAS unsigned*)(XQ + (size_t)m * DM) + F.lane;
#pragma unroll
        for (int j = 0; j < 16; ++j) dst[64 * j] = q8(v[j].x * inv) | (q8(v[j].y * inv) << 8) | (q8(v[j].z * inv) << 16) | (q8(v[j].w * inv) << 24);
        if (F.lane == 0) rowscale[m] = mx * (1.0f / 127.0f) / sqrtf(s * (1.0f / DM) + EPS);
    }
}

__device__ __forceinline__ void phase_quant_hid(Frame& F, const bf16* HIDp, const unsigned* amh, unsigned char* HQ, float* rowscale) {
    const int gw = F.vcu * 8 + F.wave, NGW = F.G * 8;
    for (int m = gw; m < M; m += NGW) {
        const GAS v4u* src = (const GAS v4u*)(HIDp + (size_t)m * FF) + F.lane;
        float amax = 0.f;
        for (int c0 = 0; c0 < 32; c0 += 8) {
            v4u w[8];
#pragma unroll
            for (int k = 0; k < 8; ++k) w[k] = src[64 * (c0 + k)];
#pragma unroll
            for (int k = 0; k < 8; ++k)
#pragma unroll
                for (int e = 0; e < 4; ++e) { const unsigned u = w[k][e]; amax = fmaxf(amax, fmaxf(__builtin_bit_cast(float, u << 16), __builtin_bit_cast(float, u & 0xffff0000u))); }
        }
        amax = wave_max(amax); (void)amh;
        const float inv = amax > 0.f ? 255.0f / amax : 0.f;
        GAS v2u* dst = (GAS v2u*)(HQ + (size_t)m * FF) + F.lane;
        for (int c0 = 0; c0 < 32; c0 += 8) {
            v4u w[8];
#pragma unroll
            for (int k = 0; k < 8; ++k) w[k] = src[64 * (c0 + k)];
#pragma unroll
            for (int k = 0; k < 8; ++k) { unsigned by[8];
#pragma unroll
                for (int e = 0; e < 4; ++e) { const unsigned u = w[k][e];
                    const float lo = __builtin_bit_cast(float, u << 16), hi = __builtin_bit_cast(float, u & 0xffff0000u);
                    by[2 * e] = (unsigned)((int)__builtin_rintf(fminf(lo * inv, 255.0f)) - 128) & 255u; by[2 * e + 1] = (unsigned)((int)__builtin_rintf(fminf(hi * inv, 255.0f)) - 128) & 255u; }
                v2u o; o.x = by[0] | (by[1] << 8) | (by[2] << 16) | (by[3] << 24); o.y = by[4] | (by[5] << 8) | (by[6] << 16) | (by[7] << 24);
                dst[64 * (c0 + k)] = o; }
        }
        if (F.lane == 0) rowscale[m] = amax * (1.0f / 255.0f);
    }
}

__device__ __forceinline__ void phase_prologue(Frame& F, const Args& a) {
    unsigned char* ws = a.ws;
    LAS float* scr = (LAS float*)(F.lds + F.wave * P0_SCR);
    const int gw = F.vcu * 8 + F.wave, NGW = F.G * 8;
    constexpr int I_POOL = (1024 / 64) * (1024 / 64);
    constexpr int I_WOUT = (VD / 64) * (DM / 64);
    constexpr int I_W2 = (FF / 64) * (DM / 64);
    constexpr int NITEMS = 4 * I_POOL + I_W2 + I_WOUT;
    constexpr int NWS = (PW + 63) / 64;
    for (int st = F.vcu; st < 2 * (FF / 64); st += F.G) { const int layer = st / (FF / 64);
        convert_strip_i8(F, a.in[13] + (size_t)layer * DM * FF, FF, ws + (layer ? WS_W1_1 : WS_W1_0), (float*)(ws + WS_CS) + layer * 16384, st % (FF / 64)); }
    for (int st = F.vcu; st < NWS; st += F.G) convert_strip_i8(F, a.in[6], PW, ws + WS_WIN, (float*)(ws + WS_CS) + 32768, st);
    const bool weighted = (F.G == 256);
    const int nshare = weighted ? (F.vcu < NWS ? 3 : 7) : 1, share0 = weighted ? (F.vcu < NWS ? 3 * F.vcu : 3 * NWS + 7 * (F.vcu - NWS)) : F.vcu, nshares = weighted ? 3 * NWS + 7 * (256 - NWS) : F.G;
    for (int sh = 0; sh < nshare; ++sh)
    for (int it = (share0 + sh) * 8 + F.wave; it < NITEMS; it += nshares * 8) {
        int r = it;
        if (r < 4 * I_POOL) { const int g = r / I_POOL; p0_transpose_item(a.in[4] + (size_t)g * 1024 * 1024, 1024, 1024, (bf16*)(ws + WS_WPOOL) + (size_t)g * 1024 * 1024, scr, r % I_POOL, F.lane); continue; } r -= 4 * I_POOL;
        if (r < I_W2) { p0_transpose_item(a.in[14], FF, DM, (bf16*)(ws + WS_W2_0), scr, r, F.lane); continue; } r -= I_W2;
        p0_transpose_item(a.in[12], VD, DM, (bf16*)(ws + WS_WOUT), scr, r, F.lane);
    }
    { GAS v4u* z = (GAS v4u*)(ws + WS_WIN + (size_t)PW * DM); const int nz = (PWP - PW) * DM / 16;
      for (int i = gw * 64 + F.lane; i < nz; i += NGW * 64) z[i] = (v4u){0u, 0u, 0u, 0u};
      float* cz = (float*)(ws + WS_CS) + 32768 + PW; for (int i = gw * 64 + F.lane; i < PWP - PW; i += NGW * 64) cz[i] = 0.f; }
    const float* x = a.in[0]; float* rstd0 = (float*)(ws + WS_RSTD0);
    for (int m = gw; m < M; m += NGW) {
        const GAS f32x4* xr = (const GAS f32x4*)(x + (size_t)m * DM) + F.lane; float s = 0.f;
#pragma unroll
        for (int j = 0; j < 16; ++j) { const f32x4 v = xr[64 * j]; s += (v.x * v.x + v.y * v.y) + (v.z * v.z + v.w * v.w); }
        s = wave_sum(s);
        if (F.lane == 0) rstd0[m] = 1.0f / sqrtf(s * (1.0f / DM) + EPS);
    }
}
__device__ __forceinline__ void convert_w1_layer1(Frame& F, const Args& a, int first) {
    LAS float* scr = (LAS float*)(F.lds + F.wave * P0_SCR);
    const int nwg = F.G - first, me = (int)blockIdx.x - first;
    if (me < 0 || nwg <= 0) return;
    (void)scr;
    for (int st = me; st < DM / 32; st += nwg) convert_strip32_i8(F, a.in[14] + (size_t)DM * FF, DM, a.ws + WS_W2_1, (float*)(a.ws + WS_CS) + 57344, st, 32);
}

__device__ __forceinline__ void phase_pooldiff(Frame& F, const Args& a) {
    const float* x = a.in[0]; const float* gmix = a.in[1]; const float* rstd0 = (const float*)(a.ws + WS_RSTD0); bf16* D = (bf16*)(a.ws + WS_D);
    for (int it = F.vcu; it < 1024; it += F.G) {
        const int half = it & 1, run = (it >> 1) & 63, b = it >> 7;
        const int c = half * 2048 + F.tid * 4, grp = c >> 10, wh = 1 << grp, t0 = run * 32;
        const f32x4 gv = *(const f32x4*)(gmix + c);
        const float* xb = x + (size_t)b * SEQ * DM + c; const float* rb = rstd0 + b * SEQ;
        f32x4 s = {0.f, 0.f, 0.f, 0.f};
        {
            f32x4 v[16]; float wgt[16];
#pragma unroll
            for (int k = 0; k < 16; ++k) { const int u = t0 - wh + k; const bool ok = (k < 2 * wh) && u >= 0 && u < SEQ; const int uc = u < 0 ? 0 : (u >= SEQ ? SEQ - 1 : u);
                v[k] = *(const f32x4*)(xb + (size_t)uc * DM); wgt[k] = ok ? rb[uc] : 0.f; }
#pragma unroll
            for (int k = 0; k < 16; ++k) s += v[k] * wgt[k];
        }
        for (int tb = 0; tb < 4; ++tb) {
            f32x4 cen[8], ad[8], sb[8]; float wc[8], wa[8], wsb[8];
#pragma unroll
            for (int k = 0; k < 8; ++k) { const int t = t0 + 8 * tb + k; const int ta = t + wh, ts = t - wh; const int tac = ta < SEQ ? ta : SEQ - 1, tsc = ts >= 0 ? ts : 0;
                cen[k] = *(const f32x4*)(xb + (size_t)t * DM); wc[k] = rb[t];
                ad[k] = *(const f32x4*)(xb + (size_t)tac * DM); wa[k] = ta < SEQ ? rb[tac] : 0.f;
                sb[k] = *(const f32x4*)(xb + (size_t)tsc * DM); wsb[k] = ts >= 0 ? rb[tsc] : 0.f; }
#pragma unroll
            for (int k = 0; k < 8; ++k) { const int t = t0 + 8 * tb + k; const int lo = (t - wh) > 0 ? (t - wh) : 0, hi = (t + wh) < SEQ ? (t + wh) : SEQ;
                const float inv = 1.0f / (float)(hi - lo);
                const f32x4 d = (s * inv - cen[k] * wc[k]) * gv;
                v2u w; w.x = pk2(d.x, d.y); w.y = pk2(d.z, d.w);
                *(v2u*)(D + ((size_t)(b * SEQ + t)) * DM + c) = w;
                s += ad[k] * wa[k]; s -= sb[k] * wsb[k]; }
        }
    }
}

#define HD __host__ __device__ __forceinline__
HD int qt_off(int p, int dk) { const int s = dk >> 5, r = dk & 31, a = r >> 4, q = (r >> 2) & 3, i = r & 3; return (((s * 4 + (p >> 4)) * 64) + (p & 15) + 16 * q) * 16 + (4 * a + i) * 2; }
HD int kt_off(int dk, int p) { return ((((dk >> 4) * 2 + (p >> 5)) * 64) + (dk & 15) + 16 * ((p >> 3) & 3)) * 16 + (p & 7) * 2; }
HD int pa_off(int i, int j) { return ((((i >> 4) * 2 + (j >> 5)) * 64) + (i & 15) + 16 * ((j >> 3) & 3)) * 16 + (j & 7) * 2; }
HD int vslot(int p) { return (p & 0x33) | (((p >> 3) & 1) << 2) | (((p >> 2) & 1) << 3); }
HD int v_off(int p, int dvl) { return (dvl >> 4) * 2048 + vslot(p) * 32 + (dvl & 15) * 2; }

typedef float f32x2_t __attribute__((ext_vector_type(2))); typedef __bf16 bf16x2_t __attribute__((ext_vector_type(2)));
typedef short v4i16_t __attribute__((ext_vector_type(4)));
__device__ __forceinline__ unsigned cvtpk(float lo, float hi) { f32x2_t v = {lo, hi}; bf16x2_t b = __builtin_convertvector(v, bf16x2_t); return __builtin_bit_cast(unsigned, b); }
__device__ __forceinline__ float dpp_row_shr(float v, int n) {
    const int iv = __builtin_bit_cast(int, v); int r;
    switch (n) { case 1: r = __builtin_amdgcn_update_dpp(0, iv, 0x111, 0xf, 0xf, true); break; case 2: r = __builtin_amdgcn_update_dpp(0, iv, 0x112, 0xf, 0xf, true); break;
                 case 4: r = __builtin_amdgcn_update_dpp(0, iv, 0x114, 0xf, 0xf, true); break; default: r = __builtin_amdgcn_update_dpp(0, iv, 0x118, 0xf, 0xf, true); break; }
    return __builtin_bit_cast(float, r);
}
__device__ __forceinline__ float wave_scan_incl(float v) {
    v += dpp_row_shr(v, 1); v += dpp_row_shr(v, 2); v += dpp_row_shr(v, 4); v += dpp_row_shr(v, 8);
    v += __builtin_bit_cast(float, __builtin_amdgcn_update_dpp(0, __builtin_bit_cast(int, v), 0x142, 0xa, 0xf, false));
    v += __builtin_bit_cast(float, __builtin_amdgcn_update_dpp(0, __builtin_bit_cast(int, v), 0x143, 0xc, 0xf, false));
    return v;
}
__device__ __forceinline__ float rdlane(float v, int l) { return __builtin_bit_cast(float, __builtin_amdgcn_readlane(__builtin_bit_cast(int, v), l)); }
__device__ __forceinline__ void glds16(const void* gsrc, unsigned lds_dst) { unsigned keep;
    asm volatile("s_mov_b32 %0, m0\n\ts_mov_b32 m0, %2\n\ts_nop 0\n\tglobal_load_lds_dwordx4 %1, off\n\ts_mov_b32 m0, %0" : "=&s"(keep) : "v"(gsrc), "s"(lds_dst) : "memory"); }
#define GLDS16(src, dst) glds16((const void*)(src), (unsigned)(uintptr_t)(dst))

__device__ __forceinline__ void phase_gla_prep(Frame& F, const Args& a) {
    unsigned char* ws = a.ws;
    const bf16* Qb = (const bf16*)(ws + WS_Q); const bf16* Kb = (const bf16*)(ws + WS_K); const float* R = (const float*)(ws + WS_R);
    LAS unsigned char* QS = F.lds; LAS unsigned char* KS = F.lds + 65536; LAS unsigned char* scr = F.lds + 131072 + F.wave * 1024;
    const int w = F.wave, p = F.lane;
    const float qscale = 0.044194173824159216f;
    for (int item = F.vcu; item < BATCH * NH * 2 * 32; item += F.G) {
        const int c = item & 31, dir = (item >> 5) & 1, h = (item >> 6) & 3, b = item >> 8;
        const int tok = b * SEQ + 64 * c + (dir ? 63 - p : p);
        typedef const __attribute__((address_space(4))) float cfloat; typedef const __attribute__((address_space(4))) f32x4 cf32x4;
        cfloat* wup = (cfloat*)(a.in[dir ? 9 : 7] + h * HK + 64 * w);
        cfloat* bup = (cfloat*)(a.in[dir ? 10 : 8] + h * HK + 64 * w);
        unsigned char* QTi = ws + WS_QT + (size_t)item * 65536; unsigned char* KTi = ws + WS_KT + (size_t)item * 65536; unsigned char* PAi = ws + WS_PA + (size_t)item * 10240;
        float* ach = (float*)(PAi + 8192);
        f32x4 rv[4];
#pragma unroll
        for (int j = 0; j < 4; ++j) rv[j] = *(const f32x4*)(R + (size_t)tok * 32 + dir * 16 + 4 * j);
        v4u qraw[8], kraw[8];
#pragma unroll
        for (int j = 0; j < 8; ++j) { qraw[j] = *(const v4u*)(Qb + (size_t)tok * KD + h * HK + 64 * w + 8 * j); kraw[j] = *(const v4u*)(Kb + (size_t)tok * KD + h * HK + 64 * w + 8 * j); }
#pragma unroll
        for (int sl = 0; sl < 2; ++sl)
#pragma unroll
            for (int q = 0; q < 4; ++q) {
                const int s = 2 * w + sl, dl = 32 * sl + 4 * q;
                float x[8];
                { const f32x4 b0 = *(cf32x4*)(bup + dl), b1 = *(cf32x4*)(bup + dl + 16);
                  x[0] = b0.x; x[1] = b0.y; x[2] = b0.z; x[3] = b0.w; x[4] = b1.x; x[5] = b1.y; x[6] = b1.z; x[7] = b1.w; }
#pragma unroll
                for (int r = 0; r < 16; ++r) { const f32x4 w0 = *(cf32x4*)(wup + r * KD + dl), w1 = *(cf32x4*)(wup + r * KD + dl + 16); const float rr = rv[r >> 2][r & 3];
                    x[0] += rr * w0.x; x[1] += rr * w0.y; x[2] += rr * w0.z; x[3] += rr * w0.w; x[4] += rr * w1.x; x[5] += rr * w1.y; x[6] += rr * w1.z; x[7] += rr * w1.w;
                    if ((r & 3) == 3) asm volatile("" ::: "memory"); }
                float qv[8], kv[8];
#pragma unroll
                for (int aa = 0; aa < 2; ++aa) { const v4u qc = qraw[4 * sl + 2 * aa + (q >> 1)], kc = kraw[4 * sl + 2 * aa + (q >> 1)];
                    const unsigned q01 = (q & 1) ? qc.z : qc.x, q23 = (q & 1) ? qc.w : qc.y, k01 = (q & 1) ? kc.z : kc.x, k23 = (q & 1) ? kc.w : kc.y;
                    qv[4 * aa + 0] = bf2f((unsigned short)(q01 & 0xffffu)); qv[4 * aa + 1] = bf2f((unsigned short)(q01 >> 16)); qv[4 * aa + 2] = bf2f((unsigned short)(q23 & 0xffffu)); qv[4 * aa + 3] = bf2f((unsigned short)(q23 >> 16));
                    kv[4 * aa + 0] = bf2f((unsigned short)(k01 & 0xffffu)); kv[4 * aa + 1] = bf2f((unsigned short)(k01 >> 16)); kv[4 * aa + 2] = bf2f((unsigned short)(k23 & 0xffffu)); kv[4 * aa + 3] = bf2f((unsigned short)(k23 >> 16)); }
                float qs_[8], ks_[8], qt_[8], kt_[8], al[8];
#pragma unroll
                for (int e = 0; e < 8; ++e) {
                    const float ls = fminf(x[e], 0.f) - __logf(1.0f + __expf(-fabsf(x[e])));
                    const float bc = wave_scan_incl(ls * (1.0f / 16.0f));
                    const float bm = rdlane(bc, 31), bl = rdlane(bc, 63);
                    const float eb = __expf(bc - bm), ebi = __expf(bm - bc), em = __expf(bm), elm = __expf(bl - bm);
                    qs_[e] = qv[e] * qscale * eb; ks_[e] = kv[e] * ebi; qt_[e] = qs_[e] * em; kt_[e] = ks_[e] * elm; al[e] = em * elm;
                }
                const int off16 = (((s * 4 + (p >> 4)) * 64) + (p & 15) + 16 * q) * 16;
                { v4u t; t.x = cvtpk(qt_[0], qt_[1]); t.y = cvtpk(qt_[2], qt_[3]); t.z = cvtpk(qt_[4], qt_[5]); t.w = cvtpk(qt_[6], qt_[7]); *(GAS v4u*)(QTi + off16) = t; }
                { v4u t; t.x = cvtpk(qs_[0], qs_[1]); t.y = cvtpk(qs_[2], qs_[3]); t.z = cvtpk(qs_[4], qs_[5]); t.w = cvtpk(qs_[6], qs_[7]); *(LAS v4u*)(QS + off16) = t; }
                { v4u t; t.x = cvtpk(ks_[0], ks_[1]); t.y = cvtpk(ks_[2], ks_[3]); t.z = cvtpk(ks_[4], ks_[5]); t.w = cvtpk(ks_[6], ks_[7]); *(LAS v4u*)(KS + off16) = t; }
                if (p == 63) { *(f32x4*)(ach + 32 * s + 4 * q) = (f32x4){al[0], al[1], al[2], al[3]}; *(f32x4*)(ach + 32 * s + 16 + 4 * q) = (f32x4){al[4], al[5], al[6], al[7]}; }
                asm volatile("" ::: "memory");
#pragma unroll
                for (int e = 0; e < 8; ++e) *(LAS unsigned short*)(scr + e * 128 + p * 2) = (unsigned short)(cvtpk(kt_[e], 0.f) & 0xffffu);
                asm volatile("s_waitcnt lgkmcnt(0)" ::: "memory");
                { const int e2 = p >> 3, n = p & 7; const v4u kk = *(const LAS v4u*)(scr + e2 * 128 + n * 16);
                  const int dk = 32 * s + 16 * (e2 >> 2) + 4 * q + (e2 & 3);
                  asm volatile("s_waitcnt lgkmcnt(0)" ::: "memory");
                  *(GAS v4u*)(KTi + kt_off(dk, 8 * n)) = kk; }
            }
        __syncthreads();
        {
            const int mj = w >> 1, mi0 = 2 * (w & 1), fr = p & 15, fq = p >> 4;
            f32x4 acc0 = {0.f, 0.f, 0.f, 0.f}, acc1 = {0.f, 0.f, 0.f, 0.f};
#pragma unroll
            for (int s = 0; s < 16; ++s) {
                const bf16x8 A = *(const LAS bf16x8*)(KS + ((s * 4 + mj) * 64 + p) * 16);
                const bf16x8 B0 = *(const LAS bf16x8*)(QS + ((s * 4 + mi0) * 64 + p) * 16), B1 = *(const LAS bf16x8*)(QS + ((s * 4 + mi0 + 1) * 64 + p) * 16);
                acc0 = __builtin_amdgcn_mfma_f32_16x16x32_bf16(A, B0, acc0, 0, 0, 0); acc1 = __builtin_amdgcn_mfma_f32_16x16x32_bf16(A, B1, acc1, 0, 0, 0);
            }
            const int j0 = 16 * mj + 4 * fq;
            { const int i = 16 * mi0 + fr; v2u t; t.x = cvtpk(j0 <= i ? acc0[0] : 0.f, j0 + 1 <= i ? acc0[1] : 0.f); t.y = cvtpk(j0 + 2 <= i ? acc0[2] : 0.f, j0 + 3 <= i ? acc0[3] : 0.f); *(GAS v2u*)(PAi + pa_off(i, j0)) = t; }
            { const int i = 16 * (mi0 + 1) + fr; v2u t; t.x = cvtpk(j0 <= i ? acc1[0] : 0.f, j0 + 1 <= i ? acc1[1] : 0.f); t.y = cvtpk(j0 + 2 <= i ? acc1[2] : 0.f, j0 + 3 <= i ? acc1[3] : 0.f); *(GAS v2u*)(PAi + pa_off(i, j0)) = t; }
        }
        __syncthreads();
    }
}

constexpr int SCAN_SUB = 32768, SCAN_PV = 26624, SCAN_PV_OFF = 3 * SCAN_SUB;
__device__ __forceinline__ void scan_issue_sub(LAS unsigned char* dst, const unsigned char* ws, int bh, int i, int w, int lane) {
    const int cs = i >> 2, j = i & 3, dir = cs >> 5, cc = cs & 31, c = dir ? 31 - cc : cc;
    const size_t item = (size_t)((bh * 2 + dir) * 32 + c);
    const unsigned char* qsrc = ws + WS_QT + item * 65536 + j * 16384 + lane * 16; const unsigned char* ksrc = ws + WS_KT + item * 65536 + j * 16384 + lane * 16;
    GLDS16(qsrc + w * 1024, dst + w * 1024); GLDS16(qsrc + (w + 8) * 1024, dst + (w + 8) * 1024);
    GLDS16(ksrc + w * 1024, dst + 16384 + w * 1024); GLDS16(ksrc + (w + 8) * 1024, dst + 16384 + (w + 8) * 1024);
}
__device__ __forceinline__ void scan_issue_pv(LAS unsigned char* slot, const unsigned char* ws, int b, int h, int sl, int cs, int k, int w, int lane) {
    const int dir = cs >> 5, cc = cs & 31, c = dir ? 31 - cc : cc;
    const size_t item = (size_t)(((b * 4 + h) * 2 + dir) * 32 + c);
    int idx = w + 8 * k; if (idx >= 26) idx -= 8;
    const unsigned char* src;
    if (idx < 10) src = ws + WS_PA + item * 10240 + idx * 1024 + lane * 16;
    else { const int kk = idx - 10, wblk = kk >> 1, slt = (kk & 1) * 32 + (lane >> 1), half = lane & 1, p = vslot(slt);
           const int tok = b * SEQ + 64 * c + (dir ? 63 - p : p);
           src = ws + WS_V + ((size_t)tok * VD + h * HV + 128 * sl + 16 * wblk + 8 * half) * 2; }
    GLDS16(src, slot + idx * 1024);
}
__device__ __forceinline__ void phase_gla_scan(Frame& F, const Args& a) {
    const unsigned char* ws = a.ws;
    LAS unsigned char* RING = F.lds; LAS unsigned char* PVS = F.lds + SCAN_PV_OFF;
    const int w = F.wave, lane = F.lane, fr = lane & 15, fq = lane >> 4;
    for (int u = F.vcu; u < BATCH * NH * 8; u += F.G) {
        const int sl = u & 7, h = (u >> 3) & 3, b = u >> 5, bh = b * 4 + h;
        f32x4 S[32];
#pragma unroll
        for (int t = 0; t < 32; ++t) S[t] = (f32x4){0.f, 0.f, 0.f, 0.f};
#pragma unroll
        for (int k = 0; k < 4; ++k) scan_issue_pv(PVS, ws, b, h, sl, 0, k, w, lane);
        scan_issue_sub(RING, ws, bh, 0, w, lane); scan_issue_sub(RING + SCAN_SUB, ws, bh, 1, w, lane);
        asm volatile("s_waitcnt vmcnt(4)" ::: "memory"); __builtin_amdgcn_s_barrier();
        int r3 = 0;
        for (int cs = 0; cs < 64; ++cs) {
            const int dir = cs >> 5, cc = cs & 31, c = dir ? 31 - cc : cc;
            if (cs == 32) {
#pragma unroll
                for (int t = 0; t < 32; ++t) S[t] = (f32x4){0.f, 0.f, 0.f, 0.f};
            }
            LAS unsigned char* pv = PVS + (cs & 1) * SCAN_PV;
            LAS unsigned char* pvn = PVS + ((cs + 1) & 1) * SCAN_PV;
            const int ncs = cs + 1 < 64 ? cs + 1 : 63;
            f32x4 o[4]; bf16x8 vB[2];
#pragma unroll
            for (int j = 0; j < 4; ++j) {
                if (j == 0) asm volatile("s_waitcnt vmcnt(20)" ::: "memory"); else asm volatile("s_waitcnt vmcnt(4)" ::: "memory");
                __builtin_amdgcn_s_barrier(); __builtin_amdgcn_sched_barrier(0);
                {
                    scan_issue_pv(pvn, ws, b, h, sl, ncs, j, w, lane);
                    int i2 = 4 * cs + j + 2; if (i2 > 255) i2 = 255;
                    int s3 = r3 + ((j + 2) % 3); if (s3 >= 3) s3 -= 3;
                    scan_issue_sub(RING + s3 * SCAN_SUB, ws, bh, i2, w, lane);
                }
                int c3 = r3 + (j % 3); if (c3 >= 3) c3 -= 3;
                LAS unsigned char* rb = RING + c3 * SCAN_SUB;
                bf16x8 f0[8]; f32x4 a4[4];
                if (j == 0) {
#pragma unroll
                    for (int m = 0; m < 4; ++m) o[m] = (f32x4){0.f, 0.f, 0.f, 0.f};
#pragma unroll
                    for (int s2 = 0; s2 < 2; ++s2) {
                        const LAS unsigned char* vb = pv + 10240 + w * 2048 + (fr & 3) * 8;
                        const v4i16_t lo = __builtin_amdgcn_ds_read_tr16_b64_v4i16((LAS v4i16_t*)(vb + vslot(32 * s2 + 8 * fq + (fr >> 2)) * 32));
                        const v4i16_t hi = __builtin_amdgcn_ds_read_tr16_b64_v4i16((LAS v4i16_t*)(vb + vslot(32 * s2 + 8 * fq + 4 + (fr >> 2)) * 32));
                        vB[s2] = __builtin_shufflevector(lo, hi, 0, 1, 2, 3, 4, 5, 6, 7);
                    }
#pragma unroll
                    for (int k = 0; k < 8; ++k) f0[k] = *(const LAS bf16x8*)(pv + (k * 64 + lane) * 16);
                    __builtin_amdgcn_sched_barrier(0);
#pragma unroll
                    for (int i = 0; i < 8; ++i) {
                        o[i >> 1] = __builtin_amdgcn_mfma_f32_16x16x32_bf16(f0[i], vB[i & 1], o[i >> 1], 0, 0, 0);
                        f0[i] = *(const LAS bf16x8*)(rb + (i * 64 + lane) * 16);
                        __builtin_amdgcn_sched_barrier(0);
                    }
                } else {
#pragma unroll
                    for (int k = 0; k < 8; ++k) f0[k] = *(const LAS bf16x8*)(rb + (k * 64 + lane) * 16);
                    __builtin_amdgcn_sched_barrier(0);
                }
                bf16x8 Bs;
#pragma unroll
                for (int i = 0; i < 16; ++i) {
                    if ((i & 3) == 0) { const int t0 = 8 * j + 2 * (i >> 2);
                        v4u pk; pk.x = cvtpk(S[t0][0], S[t0][1]); pk.y = cvtpk(S[t0][2], S[t0][3]); pk.z = cvtpk(S[t0 + 1][0], S[t0 + 1][1]); pk.w = cvtpk(S[t0 + 1][2], S[t0 + 1][3]);
                        Bs = __builtin_bit_cast(bf16x8, pk); }
                    o[i & 3] = __builtin_amdgcn_mfma_f32_16x16x32_bf16(f0[i & 7], Bs, o[i & 3], 0, 0, 0);
                    f0[i & 7] = (i < 8) ? *(const LAS bf16x8*)(rb + ((i + 8) * 64 + lane) * 16) : *(const LAS bf16x8*)(rb + 16384 + ((i - 8) * 64 + lane) * 16);
                    if (i >= 12) a4[i - 12] = *(const LAS f32x4*)(pv + 8192 + (128 * j + 16 * (i - 12) + 4 * fq) * 4);
                    __builtin_amdgcn_sched_barrier(0);
                }
#pragma unroll
                for (int i = 0; i < 16; ++i) {
                    const int tl = i >> 1, t = 8 * j + tl;
                    if ((i & 1) == 0) S[t] = S[t] * a4[tl & 3];
                    S[t] = __builtin_amdgcn_mfma_f32_16x16x32_bf16(f0[i & 7], vB[i & 1], S[t], 0, 0, 0);
                    if (i < 8) f0[i & 7] = *(const LAS bf16x8*)(rb + 16384 + ((i + 8) * 64 + lane) * 16);
                    if ((i & 1) == 1 && tl < 4) a4[tl] = *(const LAS f32x4*)(pv + 8192 + (128 * j + 16 * (tl + 4) + 4 * fq) * 4);
                    __builtin_amdgcn_sched_barrier(0);
                }
                if (j == 3) {
                    bf16* Od = (bf16*)(a.ws + (dir ? WS_OB : WS_OF)) + (size_t)h * HV + 128 * sl + 16 * w + fr;
#pragma unroll
                    for (int m = 0; m < 4; ++m)
#pragma unroll
                        for (int r = 0; r < 4; ++r) { const int p = 16 * m + 4 * fq + r; const int tok = b * SEQ + 64 * c + (dir ? 63 - p : p); Od[(size_t)tok * VD] = (bf16)(cvtpk(o[m][r], 0.f) & 0xffffu); }
                }
            }
            r3 = r3 + 1; if (r3 == 3) r3 = 0;
        }
        asm volatile("s_waitcnt vmcnt(0)" ::: "memory"); __builtin_amdgcn_s_barrier();
    }
}

__device__ __forceinline__ void phase_post(Frame& F, const Args& a) {
    const bf16* O = (const bf16*)(a.ws + WS_OF); const bf16* O2 = (const bf16*)(a.ws + WS_OB); const bf16* Gt = (const bf16*)(a.ws + WS_G); bf16* XA = (bf16*)(a.ws + WS_D); const float* gn = a.in[11];
    const int gw = F.vcu * 8 + F.wave, NGW = F.G * 8;
    f32x4 gv[4];
#pragma unroll
    for (int j = 0; j < 4; ++j) gv[j] = *(const f32x4*)(gn + F.lane * 4 + 256 * j);
    for (int it = gw; it < M * NH; it += NGW) {
        const size_t base = (size_t)(it >> 2) * VD + (it & 3) * HV + F.lane * 4;
        f32x4 o[4]; float s = 0.f;
#pragma unroll
        for (int j = 0; j < 4; ++j) { const v2u a2 = *(const v2u*)(O + base + 256 * j), b2 = *(const v2u*)(O2 + base + 256 * j);
            o[j].x = bf2f((unsigned short)(a2.x & 0xffffu)) + bf2f((unsigned short)(b2.x & 0xffffu)); o[j].y = bf2f((unsigned short)(a2.x >> 16)) + bf2f((unsigned short)(b2.x >> 16));
            o[j].z = bf2f((unsigned short)(a2.y & 0xffffu)) + bf2f((unsigned short)(b2.y & 0xffffu)); o[j].w = bf2f((unsigned short)(a2.y >> 16)) + bf2f((unsigned short)(b2.y >> 16));
            s += (o[j].x * o[j].x + o[j].y * o[j].y) + (o[j].z * o[j].z + o[j].w * o[j].w); }
        s = wave_sum(s); const float rs = 1.0f / sqrtf(s * (1.0f / HV) + EPS);
#pragma unroll
        for (int j = 0; j < 4; ++j) {
            const v2u gw2 = *(const v2u*)(Gt + base + 256 * j);
            const float g0 = bf2f((unsigned short)(gw2.x & 0xffffu)), g1 = bf2f((unsigned short)(gw2.x >> 16)), g2 = bf2f((unsigned short)(gw2.y & 0xffffu)), g3 = bf2f((unsigned short)(gw2.y >> 16));
            const f32x4 y = o[j] * rs * gv[j];
            const float r0 = y.x * g0 / (1.0f + __expf(-g0)), r1 = y.y * g1 / (1.0f + __expf(-g1)), r2 = y.z * g2 / (1.0f + __expf(-g2)), r3 = y.w * g3 / (1.0f + __expf(-g3));
            v2u w; w.x = pk2(r0, r1); w.y = pk2(r2, r3);
            *(v2u*)(XA + base + 256 * j) = w;
        }
    }
}
__device__ __forceinline__ void phase_final(Frame& F, const Args& a) {
    float* H = a.out; const float* ss = (const float*)(a.ws + WS_CTL) + CW_SS + 3 * M; const float* gf = a.in[3];
    const int gw = F.vcu * 8 + F.wave, NGW = F.G * 8;
    for (int m = gw; m < M; m += NGW) {
        const float rs = 1.0f / sqrtf(ld_agent(ss + m) * (1.0f / DM) + EPS);
        f32x4* hr = (f32x4*)(H + (size_t)m * DM) + F.lane;
#pragma unroll
        for (int j = 0; j < 16; ++j) { const f32x4 g = *((const f32x4*)gf + F.lane + 64 * j); hr[64 * j] = hr[64 * j] * rs * g; }
    }
}

__device__ __forceinline__ void final_norm_own_tiles(Frame& F, const Args& a, const pg8::StaticOrder& S, unsigned* ctl) {
    pg8::Unit u0; if (!S.next(0, u0)) return;
    asm volatile("s_waitcnt vmcnt(0)" ::: "memory");
    __syncthreads();
    if (F.tid == 0) {
        unsigned* cnt = ctl + CW_PAN + 64 * u0.pm; unsigned* bar = ctl + CW_BAR;
        __builtin_amdgcn_fence(__ATOMIC_RELEASE, "agent");
        asm volatile("s_waitcnt vmcnt(0)" ::: "memory");
        (void)xb_add(cnt, 1u);
        XB_SPIN(xb_ld(cnt) < 4u, bar);
        __builtin_amdgcn_fence(__ATOMIC_ACQUIRE, "agent");
        asm volatile("s_waitcnt vmcnt(0)" ::: "memory");
    }
    __syncthreads();
    float* H = a.out; const float* ss = (const float*)(a.ws + WS_CTL) + CW_SS + 3 * M; const float* gf = a.in[3];
    pg8::Unit u;
    for (int i = 0; S.next(i, u); ++i) {
        const f32x4 g = *(const f32x4*)(gf + u.pn * 256 + F.lane * 4);
        for (int r0 = 0; r0 < 256; r0 += 64) {
            f32x4 v[8]; float sq[8];
#pragma unroll
            for (int k = 0; k < 8; ++k) { const int row = u.pm * 256 + r0 + 8 * k + F.wave;
                sq[k] = ld_agent(ss + row); v[k] = *((const f32x4*)(H + (size_t)row * DM + u.pn * 256) + F.lane); }
#pragma unroll
            for (int k = 0; k < 8; ++k) { const int row = u.pm * 256 + r0 + 8 * k + F.wave; const float rs = 1.0f / sqrtf(sq[k] * (1.0f / DM) + EPS);
                *((f32x4*)(H + (size_t)row * DM + u.pn * 256) + F.lane) = v[k] * rs * g; }
        }
    }
}

struct EpiResidFin {
    static constexpr bool PERM = true, AFTER_DRAIN = false;
    float* H; float* ss; const float* gf; unsigned* ctl; int tid;
    __device__ __forceinline__ void pre(const pg8::Unit&, int, int, float (&p)[8]) const { _Pragma("unroll") for (int i = 0; i < 8; ++i) p[i] = 0.f; }
    __device__ __forceinline__ void operator()(f32x4 (&acc)[2][2][4][2], const pg8::Unit& u, int wr, int wc, int fr, int fq, const float (&)[8]) const {
        using namespace pg8;
        const int row0 = u.pm * BM + wr * 64 + fr, col0 = u.pn * BM + wc * 32 + 8 * fq;
        const bool lastu = u.pn >= 12;
#pragma unroll
        for (int ai = 0; ai < 2; ++ai)
#pragma unroll
            for (int m = 0; m < 4; ++m) {
                const int r = row0 + ai * HALF + m * 16; const size_t off = (size_t)r * DM + col0; float s = 0.f;
#pragma unroll
                for (int bj = 0; bj < 2; ++bj) {
                    const f32x4 h0 = *(const f32x4*)(H + off + bj * HALF), h1 = *(const f32x4*)(H + off + bj * HALF + 4);
                    const f32x4 v0 = h0 + acc[ai][bj][m][0], v1 = h1 + acc[ai][bj][m][1];
                    if (lastu) { acc[ai][bj][m][0] = v0; acc[ai][bj][m][1] = v1; }
                    else { *(f32x4*)(H + off + bj * HALF) = v0; *(f32x4*)(H + off + bj * HALF + 4) = v1; }
                    s += (v0[0] * v0[0] + v0[1] * v0[1]) + (v0[2] * v0[2] + v0[3] * v0[3]) + (v1[0] * v1[0] + v1[1] * v1[1]) + (v1[2] * v1[2] + v1[3] * v1[3]);
                }
                s += __shfl_xor(s, 16); s += __shfl_xor(s, 32);
                if (fq == 0) unsafeAtomicAdd(ss + r, s);
                if (m & 1) asm volatile("" ::: "memory");
            }
        if (!lastu) return;
        asm volatile("s_waitcnt vmcnt(0)" ::: "memory");
        __syncthreads();
        if (tid == 0) {
            unsigned* cnt = ctl + CW_PAN + 64 * u.pm; unsigned* bar = ctl + CW_BAR;
            __builtin_amdgcn_fence(__ATOMIC_RELEASE, "agent");
            asm volatile("s_waitcnt vmcnt(0)" ::: "memory");
            (void)xb_add(cnt, 1u);
            XB_SPIN(xb_ld(cnt) < 4u, bar);
            __builtin_amdgcn_fence(__ATOMIC_ACQUIRE, "agent");
            asm volatile("s_waitcnt vmcnt(0)" ::: "memory");
        }
        __syncthreads();
        f32x4 g[2][2];
#pragma unroll
        for (int bj = 0; bj < 2; ++bj)
#pragma unroll
            for (int n = 0; n < 2; ++n) g[bj][n] = *(const f32x4*)(gf + col0 + bj * HALF + 4 * n);
#pragma unroll
        for (int ai = 0; ai < 2; ++ai)
#pragma unroll
            for (int m = 0; m < 4; ++m) {
                const int r = row0 + ai * HALF + m * 16; const size_t off = (size_t)r * DM + col0;
                const float rs = 1.0f / sqrtf(ld_agent(ss + r) * (1.0f / DM) + EPS);
#pragma unroll
                for (int bj = 0; bj < 2; ++bj) { *(f32x4*)(H + off + bj * HALF) = acc[ai][bj][m][0] * rs * g[bj][0]; *(f32x4*)(H + off + bj * HALF + 4) = acc[ai][bj][m][1] * rs * g[bj][1]; }
            }
    }
};
__device__ __forceinline__ void final_norm_rest(Frame& F, const Args& a, const pg8::StaticOrder& S) {
    asm volatile("s_waitcnt vmcnt(0)" ::: "memory");
    __syncthreads();
    float* H = a.out; const float* ss = (const float*)(a.ws + WS_CTL) + CW_SS + 3 * M; const float* gf = a.in[3];
    pg8::Unit u;
    for (int i = 0; S.next(i, u); ++i) {
        if (u.pn >= 12) continue;
        const f32x4 g = *(const f32x4*)(gf + u.pn * 256 + F.lane * 4);
        for (int r0 = 0; r0 < 256; r0 += 64) {
            f32x4 v[8]; float sq[8];
#pragma unroll
            for (int k = 0; k < 8; ++k) { const int row = u.pm * 256 + r0 + 8 * k + F.wave;
                sq[k] = ld_agent(ss + row); v[k] = *((const f32x4*)(H + (size_t)row * DM + u.pn * 256) + F.lane); }
#pragma unroll
            for (int k = 0; k < 8; ++k) { const int row = u.pm * 256 + r0 + 8 * k + F.wave; const float rs = 1.0f / sqrtf(sq[k] * (1.0f / DM) + EPS);
                *((f32x4*)(H + (size_t)row * DM + u.pn * 256) + F.lane) = v[k] * rs * g; }
        }
    }
}

struct EpiResidI8 {
    static constexpr bool PERM = true, AFTER_DRAIN = false;
    float* H; const float* rsc; const float* cscl; const int* coff; float* ss; const float* gf; unsigned* ctl; int tid, fin;
    __device__ __forceinline__ void pre(const pg8::Unit& u, int wr, int fr, float (&p)[8]) const { const int row0 = u.pm * pg8::BM + wr * 64 + fr;
        _Pragma("unroll") for (int i = 0; i < 8; ++i) p[i] = rsc[row0 + (i >> 2) * pg8::HALF + (i & 3) * 16]; }
    __device__ __forceinline__ void operator()(i32x4 (&acc)[2][2][4][2], const pg8::Unit& u, int wr, int wc, int fr, int fq, const float (&p)[8]) const {
        using namespace pg8;
        const int row0 = u.pm * BM + wr * 64 + fr, col0 = u.pn * BM + wc * 32 + 8 * fq;
        const bool lastu = fin && u.pn >= 12;
#pragma unroll
        for (int ai = 0; ai < 2; ++ai)
#pragma unroll
            for (int m = 0; m < 4; ++m) {
                const int r = row0 + ai * HALF + m * 16; const size_t off = (size_t)r * DM + col0; float s = 0.f; const float rsf = p[ai * 4 + m];
#pragma unroll
                for (int bj = 0; bj < 2; ++bj) {
                    const f32x4 h0 = *(const f32x4*)(H + off + bj * HALF), h1 = *(const f32x4*)(H + off + bj * HALF + 4);
                    const f32x4 c0 = *(const f32x4*)(cscl + col0 + bj * HALF), c1 = *(const f32x4*)(cscl + col0 + bj * HALF + 4);
                    const i32x4 o0 = *(const i32x4*)(coff + col0 + bj * HALF), o1 = *(const i32x4*)(coff + col0 + bj * HALF + 4);
                    const f32x4 v0 = h0 + __builtin_convertvector(acc[ai][bj][m][0] + o0, f32x4) * (c0 * rsf);
                    const f32x4 v1 = h1 + __builtin_convertvector(acc[ai][bj][m][1] + o1, f32x4) * (c1 * rsf);
                    if (!lastu) { *(f32x4*)(H + off + bj * HALF) = v0; *(f32x4*)(H + off + bj * HALF + 4) = v1; }
                    acc[ai][bj][m][0] = __builtin_bit_cast(i32x4, v0); acc[ai][bj][m][1] = __builtin_bit_cast(i32x4, v1);
                    s += (v0[0] * v0[0] + v0[1] * v0[1]) + (v0[2] * v0[2] + v0[3] * v0[3]) + (v1[0] * v1[0] + v1[1] * v1[1]) + (v1[2] * v1[2] + v1[3] * v1[3]);
                }
                if (ss) { s += __shfl_xor(s, 16); s += __shfl_xor(s, 32); if (fq == 0) unsafeAtomicAdd(ss + r, s); }
                if (m & 1) asm volatile("" ::: "memory");
            }
        if (!lastu) return;
        asm volatile("s_waitcnt vmcnt(0)" ::: "memory");
        __syncthreads();
        if (tid == 0) {
            unsigned* cnt = ctl + CW_PAN + 64 * u.pm; unsigned* bar = ctl + CW_BAR;
            __builtin_amdgcn_fence(__ATOMIC_RELEASE, "agent");
            asm volatile("s_waitcnt vmcnt(0)" ::: "memory");
            (void)xb_add(cnt, 1u);
            XB_SPIN(xb_ld(cnt) < 4u, bar);
            __builtin_amdgcn_fence(__ATOMIC_ACQUIRE, "agent");
            asm volatile("s_waitcnt vmcnt(0)" ::: "memory");
        }
        __syncthreads();
        f32x4 g[2][2];
#pragma unroll
        for (int bj = 0; bj < 2; ++bj)
#pragma unroll
            for (int n = 0; n < 2; ++n) g[bj][n] = *(const f32x4*)(gf + col0 + bj * HALF + 4 * n);
#pragma unroll
        for (int ai = 0; ai < 2; ++ai)
#pragma unroll
            for (int m = 0; m < 4; ++m) {
                const int r = row0 + ai * HALF + m * 16; const size_t off = (size_t)r * DM + col0;
                const float rs = 1.0f / sqrtf(ld_agent(ss + r) * (1.0f / DM) + EPS);
#pragma unroll
                for (int bj = 0; bj < 2; ++bj) { *(f32x4*)(H + off + bj * HALF) = __builtin_bit_cast(f32x4, acc[ai][bj][m][0]) * rs * g[bj][0]; *(f32x4*)(H + off + bj * HALF + 4) = __builtin_bit_cast(f32x4, acc[ai][bj][m][1]) * rs * g[bj][1]; }
            }
    }
};

__global__ void __launch_bounds__(512, 2) mk_fwd(Args args) {
    extern __shared__ __attribute__((aligned(16))) unsigned char lds[];
    Frame F;
    F.lds = (LAS unsigned char*)lds;
    F.tid = threadIdx.x; F.lane = F.tid & 63; F.wave = __builtin_amdgcn_readfirstlane(F.tid >> 6);
    F.G = gridDim.x; { const int bx = blockIdx.x; F.vcu = (F.G % 8 == 0) ? (bx % 8) * (F.G / 8) + bx / 8 : bx; }
    volatile LAS unsigned* MISC = (volatile LAS unsigned*)(F.lds + MISC_OFF);
    if (F.tid < 64) MISC[F.tid] = 0u;
    __syncthreads();
    unsigned char* ws = args.ws;
    unsigned* ctl = (unsigned*)(ws + WS_CTL);
    const int lo = args.ph_lo, hi = args.ph_hi;
    XcdBarrier bar; bar.bar = ctl + CW_BAR; bar.x = 0; bar.st = nullptr;
    if (hi - lo > 1) bar = xcd_barrier_post(ctl + CW_BAR, MISC + 8);
#define IN(k) (lo <= (k) && (k) < hi)
#define SEAM(k) do { if ((PROBE_MASK >> (k)) & 1u) { const unsigned long long _t1 = __builtin_amdgcn_s_memrealtime(), _d = _t1 - pt0; while (__builtin_amdgcn_s_memrealtime() - _t1 < _d) __builtin_amdgcn_s_sleep(8); } \
    if (IN(k) && IN((k) + 1)) xcd_barrier(bar); if (PROBE_MASK) pt0 = __builtin_amdgcn_s_memrealtime(); } while (0)
    unsigned long long pt0 = PROBE_MASK ? __builtin_amdgcn_s_memrealtime() : 0ull;
    float* SS = (float*)ctl + CW_SS;
    float* H = args.out;
    bf16* XN = (bf16*)(ws + WS_XN); bf16* Db = (bf16*)(ws + WS_D); bf16* HID = (bf16*)(ws + WS_HID);
    const float* norm_mix = args.in[1]; const float* norm_mlp = args.in[2];

    unsigned char* XQ = ws + WS_XN;
    float* RS = (float*)(ws + WS_RS); const float* CS = (const float*)(ws + WS_CS);
    const bool fused_final = IN(15) && IN(16) && F.G == 256;
    if (IN(0)) { phase_prologue(F, args); } SEAM(0);
    if (IN(1)) {
        phase_pooldiff(F, args); } SEAM(1);
    if (IN(2)) {
        pg8::Gemm g{Db, (const bf16*)(ws + WS_WPOOL), M, DM, 1024, DM, 4}; pg8::StaticOrder S; S.init(M, DM, F.G, (int)blockIdx.x);
        pg8::EpiResid E{args.in[0], H, args.in[5], nullptr, nullptr, nullptr, DM, 1};
        pg8::gemm_phase<pg8::EpiResid, pg8::StaticOrder>(F.lds, g, S, E);
    } SEAM(2);
    if (IN(3)) { phase_quant(F, H, norm_mlp, XQ, RS + 0 * M); } SEAM(3);
    if (IN(4)) {
        pg8::Gemm g{(const bf16*)XQ, (const bf16*)(ws + WS_W1_0), M, FF, DM / 2, DM / 2, 0}; pg8::StaticOrder S; S.init(M, FF, F.G, (int)blockIdx.x);
        pg8::EpiRelu2Q E{HID, FF, RS + 0 * M, CS, nullptr};
        pg8::gemm_phase<pg8::EpiRelu2Q, pg8::StaticOrder, true, true>(F.lds, g, S, E);
    } SEAM(4);
    if (IN(5)) {
        pg8::Gemm g{HID, (const bf16*)(ws + WS_W2_0), M, DM, FF, FF, 0}; pg8::StaticOrder S; S.init(M, DM, F.G, (int)blockIdx.x);
        pg8::EpiResid E{H, H, nullptr, nullptr, nullptr, nullptr, DM, 0};
        pg8::gemm_phase<pg8::EpiResid, pg8::StaticOrder>(F.lds, g, S, E);
    } SEAM(5);
    if (IN(6)) { phase_quant(F, H, norm_mix + DM, XQ, RS + 1 * M); } SEAM(6);
    if (IN(7)) {
        pg8::Gemm g{(const bf16*)XQ, (const bf16*)(ws + WS_WIN), M, PWP, DM / 2, DM / 2, 0}; pg8::StaticOrder S; S.init(M, PWP, F.G, (int)blockIdx.x);
        pg8::EpiInProjQ E{(bf16*)(ws + WS_Q), (bf16*)(ws + WS_K), (bf16*)(ws + WS_V), (bf16*)(ws + WS_G), (float*)(ws + WS_R), RS + 1 * M, CS + 32768};
        pg8::gemm_phase<pg8::EpiInProjQ, pg8::StaticOrder, true, true>(F.lds, g, S, E);
        const int n13 = (M / 256) * (PWP / 256) - 12 * F.G;
        if (F.G == 256) convert_w1_layer1(F, args, n13); else convert_w1_layer1(F, args, 0);
    } SEAM(7);
    if (IN(8)) { phase_gla_prep(F, args); } SEAM(8);
    if (IN(9)) { phase_gla_scan(F, args); } SEAM(9);
    if (IN(10)) { phase_post(F, args); } SEAM(10);
    if (IN(11)) {
        pg8::Gemm g{Db, (const bf16*)(ws + WS_WOUT), M, DM, VD, VD, 0}; pg8::StaticOrder S; S.init(M, DM, F.G, (int)blockIdx.x);
        pg8::EpiResid E{H, H, nullptr, nullptr, nullptr, nullptr, DM, 1};
        pg8::gemm_phase<pg8::EpiResid, pg8::StaticOrder>(F.lds, g, S, E);
    } SEAM(11);
    if (IN(12)) { phase_quant(F, H, norm_mlp + DM, XQ, RS + 2 * M); } SEAM(12);
    if (IN(13)) {
        pg8::Gemm g{(const bf16*)XQ, (const bf16*)(ws + WS_W1_1), M, FF, DM / 2, DM / 2, 0}; pg8::StaticOrder S; S.init(M, FF, F.G, (int)blockIdx.x);
        pg8::EpiRelu2Q E{HID, FF, RS + 2 * M, CS + 16384, nullptr};
        pg8::gemm_phase<pg8::EpiRelu2Q, pg8::StaticOrder, true, true>(F.lds, g, S, E);
    } SEAM(13);
    if (IN(14)) { phase_quant_hid(F, HID, (const unsigned*)(SS + 0 * M), ws + WS_HIDQ, (float*)(ws + WS_RSTD0));
        {
            float* cs2 = (float*)(ws + WS_CS) + 49152; int* co2 = (int*)(ws + WS_CS) + 53248;
            for (int n = F.vcu * 8 + F.wave; n < DM; n += F.G * 8) {
                const GAS v4u* rowp = (const GAS v4u*)(ws + WS_W2_1 + (size_t)n * FF) + F.lane; int sq = 0;
#pragma unroll
                for (int j = 0; j < 16; ++j) { const v4u w = rowp[64 * j];
#pragma unroll
                    for (int e = 0; e < 4; ++e) { const int u = (int)w[e]; sq += (int)(signed char)(u & 255) + (int)(signed char)((u >> 8) & 255) + (int)(signed char)((u >> 16) & 255) + (u >> 24); } }
#pragma unroll
                for (int o = 1; o < 64; o <<= 1) sq += __shfl_xor(sq, o);
                if (F.lane == 0) { cs2[n] = ((const float*)(ws + WS_CS))[57344 + n]; co2[n] = 128 * sq; }
            } }
    } SEAM(14);
    if (IN(15)) {
        pg8::Gemm g{(const bf16*)(ws + WS_HIDQ), (const bf16*)(ws + WS_W2_1), M, DM, FF / 2, FF / 2, 0}; pg8::StaticOrder S; S.init(M, DM, F.G, (int)blockIdx.x);
        EpiResidI8 E{H, (const float*)(ws + WS_RSTD0), (const float*)(ws + WS_CS) + 49152, (const int*)(ws + WS_CS) + 53248, SS + 3 * M, args.in[3], ctl, F.tid, fused_final ? 1 : 0};
        pg8::gemm_phase<EpiResidI8, pg8::StaticOrder, true, true>(F.lds, g, S, E);
        if (fused_final) final_norm_rest(F, args, S);
    } if (!fused_final) SEAM(15);
    if (IN(16) && !fused_final) { phase_final(F, args); } SEAM(16);
#undef IN
#undef SEAM
}

extern "C" void kernel_launch(void* const* d_in, const int* in_sizes, int n_in, void* d_out, int out_size, void* d_ws, size_t ws_size, hipStream_t stream) {
    static int grid = 0;
    if (grid == 0) {
        if (n_in != 15 || in_sizes[0] != M * DM || out_size != M * DM || ws_size < WS_END) {
            fprintf(stderr, "kernel_launch: unexpected problem (n_in %d, in0 %d, out %d, ws %zu < %zu); nothing launched\n", n_in, n_in > 0 ? in_sizes[0] : -1, out_size, ws_size, (size_t)WS_END); grid = -1; return; }
        int dev = 0, cus = 0;
        if (hipGetDevice(&dev) != hipSuccess || hipDeviceGetAttribute(&cus, hipDeviceAttributeMultiprocessorCount, dev) != hipSuccess) { grid = -1; return; }
        if (hipFuncSetAttribute((const void*)mk_fwd, hipFuncAttributeMaxDynamicSharedMemorySize, LDS_BYTES) != hipSuccess) { fprintf(stderr, "kernel_launch: hipFuncSetAttribute failed\n"); grid = -1; return; }
        int per_cu = 0;
        if (hipOccupancyMaxActiveBlocksPerMultiprocessor(&per_cu, (const void*)mk_fwd, 512, LDS_BYTES) != hipSuccess || per_cu < 1) fprintf(stderr, "kernel_launch: occupancy query says %d\n", per_cu);
        (void)hipGetLastError();
        grid = cus;
    }
    if (grid < 0) return;
    (void)hipMemsetAsync((char*)d_ws + WS_CTL, 0, CTL_ZERO_BYTES, stream);
    Args a{};
    for (int i = 0; i < 15; ++i) a.in[i] = (const float*)d_in[i];
    a.out = (float*)d_out; a.ws = (unsigned char*)d_ws;
#if MK_PER_PHASE
    for (int p = 0; p < NPHASE; ++p) { a.ph_lo = p; a.ph_hi = p + 1; hipLaunchKernelGGL(mk_fwd, dim3(grid), dim3(512), LDS_BYTES, stream, a); }
#else
    a.ph_lo = 0; a.ph_hi = NPHASE; hipLaunchKernelGGL(mk_fwd, dim3(grid), dim3(512), LDS_BYTES, stream, a);
#endif
}
```
